# Optimizing an MI355X kernel written in HIP

```python
import math
import jax, jax.numpy as jnp
from jax import lax
import numpy as np

D_MODEL = 1024
BATCH = 4
SEQ = 4096
DEPTH = 1
DEC_BATCH = 32
DEC_SEQ = 16
PAST_LEN = 1024

CHUNK = 64
N_META = 16
Q_BLOCK = 128
SB_HEADS = 16
SB_HEAD_DIM = 64
SB_WIDTH = SB_HEADS * SB_HEAD_DIM
SSD_WIDTH = 2 * D_MODEL
SSD_HEAD_DIM = 64
SSD_HEADS = SSD_WIDTH // SSD_HEAD_DIM
SSD_GROUPS = 4
SSD_HEADS_PER_GROUP = SSD_HEADS // SSD_GROUPS
SSD_STATE = 128
SSD_CONV = 4
SSD_CONV_CH = SSD_WIDTH + 2 * SSD_GROUPS * SSD_STATE
D_FF = ((8 * D_MODEL // 3 + 127) // 128) * 128
FFN_CONV = 3
N_BRANCH = 2
IN_COLS = 3 * SB_WIDTH + SSD_WIDTH + SSD_CONV_CH + SSD_HEADS + N_BRANCH * D_MODEL
EPS = 1e-6

kernel_name = 'streaming_stickbreak_ssd_hybrid_step'


def rms_norm(x, g):
    xf = x.astype(jnp.float32)
    y = xf * lax.rsqrt(jnp.mean(xf * xf, axis=-1, keepdims=True) + EPS)
    return (y * g.astype(jnp.float32)).astype(x.dtype)


def causal_dwconv(x, prev, w, bias):
    k_width, length = w.shape[0], x.shape[1]
    xp = jnp.concatenate([prev.astype(x.dtype), x], axis=1)
    y = bias
    for i in range(k_width):
        y = y + xp[:, i:i + length] * w[i]
    return y, xp[:, length:]


def stick_breaking(q, k, v, q_pos, k_pos):
    z = jnp.einsum('bqhd,bshd->bhqs', q, k).astype(jnp.float32) * (SB_HEAD_DIM ** -0.5)
    reach = k_pos[None, :] < q_pos[:, None]
    log_beta = jax.nn.log_sigmoid(z)
    log_keep = jnp.where(reach, jax.nn.log_sigmoid(-z), 0.0)
    later = lax.cumsum(log_keep, axis=3, reverse=True) - log_keep
    w = jnp.where(reach, jnp.exp(log_beta + later), 0.0)
    return jnp.einsum('bhqs,bshd->bqhd', w.astype(v.dtype), v)


def stick_breaking_prompt(q, k, v):
    b, length, h, d = q.shape
    nb = -(-length // Q_BLOCK)
    pad = nb * Q_BLOCK - length
    qb = jnp.pad(q, ((0, 0), (0, pad), (0, 0), (0, 0))).reshape(b, nb, Q_BLOCK, h, d).transpose(1, 0, 2, 3, 4)
    q_pos = jnp.arange(nb * Q_BLOCK).reshape(nb, Q_BLOCK)
    k_pos = jnp.arange(length)
    out = lax.map(lambda blk: stick_breaking(blk[0], k, v, blk[1], k_pos), (qb, q_pos))
    return out.transpose(1, 0, 2, 3, 4).reshape(b, nb * Q_BLOCK, h, d)[:, :length]


def ssd_scan(x, dt, a_head, b_in, c_in, h0, pad_left):
    bsz, length = x.shape[:2]
    G, R, P, N = SSD_GROUPS, SSD_HEADS_PER_GROUP, SSD_HEAD_DIM, SSD_STATE
    pad_right = (-(pad_left + length)) % CHUNK
    nc = (pad_left + length + pad_right) // CHUNK

    def chunked(t):
        t = jnp.pad(t, [(0, 0), (pad_left, pad_right)] + [(0, 0)] * (t.ndim - 2))
        return t.reshape((bsz, nc, CHUNK) + t.shape[2:])

    xc = chunked(x).reshape(bsz, nc, CHUNK, G, R, P)
    dtc = chunked(dt).reshape(bsz, nc, CHUNK, G, R)
    bc, cc = chunked(b_in), chunked(c_in)
    dt_t = jnp.moveaxis(dtc, 2, -1)
    a_cum = jnp.cumsum(dt_t * a_head.reshape(G, R)[..., None], axis=-1)
    causal = jnp.tril(jnp.ones((CHUNK, CHUNK), dtype=bool))
    decay_ts = jnp.exp(jnp.where(causal, a_cum[..., :, None] - a_cum[..., None, :], -jnp.inf))
    cb = jnp.einsum('bctgn,bcsgn->bcgts', cc, bc)
    y_diag = jnp.einsum('bcgrts,bcsgrp->bctgrp', cb[:, :, :, None] * decay_ts * dt_t[..., None, :], xc)
    to_end = jnp.exp(a_cum[..., -1:] - a_cum) * dt_t
    chunk_states = jnp.einsum('bcgrs,bcsgn,bcsgrp->bcgrpn', to_end, bc, xc)
    chunk_decay = jnp.exp(a_cum[..., -1])

    def step(h, inp):
        dec, st = inp
        return dec[..., None, None] * h + st, h

    h_init = h0.reshape(bsz, G, R, P, N).astype(jnp.float32)
    h_final, h_in = lax.scan(step, h_init, (jnp.moveaxis(chunk_decay, 1, 0), jnp.moveaxis(chunk_states, 1, 0)))
    h_in = jnp.moveaxis(h_in, 0, 1)
    y_off = jnp.einsum('bctgn,bcgrpn,bcgrt->bctgrp', cc, h_in, jnp.exp(a_cum))
    y = (y_diag + y_off).reshape(bsz, nc * CHUNK, G * R, P)[:, pad_left:pad_left + length]
    return y.astype(x.dtype), h_final.reshape(bsz, G * R, P, N).astype(h0.dtype)


def ssd_mix(xbc, z, dt_raw, conv_prev, h0, conv_w, conv_b, dt_bias, a_log, d_skip, g_norm, pad_left):
    bsz, length, _ = xbc.shape
    xbc, conv_state = causal_dwconv(xbc, conv_prev, conv_w, conv_b)
    xbc = jax.nn.silu(xbc)
    xs, b_in, c_in = jnp.split(xbc, [SSD_WIDTH, SSD_WIDTH + SSD_GROUPS * SSD_STATE], axis=-1)
    xs = xs.reshape(bsz, length, SSD_HEADS, SSD_HEAD_DIM)
    b_in = b_in.reshape(bsz, length, SSD_GROUPS, SSD_STATE)
    c_in = c_in.reshape(bsz, length, SSD_GROUPS, SSD_STATE)
    dt = jax.nn.softplus(dt_raw.astype(jnp.float32) + dt_bias.astype(jnp.float32))
    a_head = -jnp.exp(a_log.astype(jnp.float32))
    y, h_final = ssd_scan(xs, dt, a_head, b_in, c_in, h0, pad_left)
    y = (y + d_skip[:, None] * xs).reshape(bsz, length, SSD_WIDTH) * jax.nn.silu(z)
    y = rms_norm(y.reshape(bsz, length, SSD_GROUPS, SSD_WIDTH // SSD_GROUPS), g_norm.reshape(SSD_GROUPS, -1))
    return y.reshape(bsz, length, SSD_WIDTH), h_final, conv_state


def trunk_layer(h, p, kv_past, ssd_h0, ssd_conv_prev, ffn_conv_prev, pad_left):
    bsz, length, _ = h.shape
    u = rms_norm(h, p['g_mix'])
    proj = u @ p['w_in']
    sizes = [SB_WIDTH, SB_WIDTH, SB_WIDTH, SSD_WIDTH, SSD_CONV_CH, SSD_HEADS, N_BRANCH * D_MODEL]
    q, k, v, z, xbc, dt_raw, gate_logits = jnp.split(proj, np.cumsum(sizes)[:-1].tolist(), axis=-1)
    q, k, v = (t.reshape(bsz, length, SB_HEADS, SB_HEAD_DIM) for t in (q, k, v))
    if kv_past is None:
        att = stick_breaking_prompt(q, k, v)
    else:
        n_past = kv_past[0].shape[1]
        k_all = jnp.concatenate([kv_past[0].astype(k.dtype), k], axis=1)
        v_all = jnp.concatenate([kv_past[1].astype(v.dtype), v], axis=1)
        att = stick_breaking(q, k_all, v_all, n_past + jnp.arange(length), jnp.arange(n_past + length))
    ssd, ssd_state, ssd_conv = ssd_mix(xbc, z, dt_raw, ssd_conv_prev, ssd_h0, p['conv_w_ssd'], p['conv_b_ssd'],
                                       p['dt_bias'], p['a_log'], p['d_skip'], p['g_ssd_norm'], pad_left)
    gate_att, gate_ssd = jnp.split(jax.nn.sigmoid(gate_logits), 2, axis=-1)
    merged = (gate_att * (att.reshape(bsz, length, SB_WIDTH) @ p['w_br_att'])
              + gate_ssd * (ssd @ p['w_br_ssd']))
    h = h + merged @ p['w_out']
    u = rms_norm(h, p['g_ffn'])
    up, ffn_conv = causal_dwconv(u @ p['w_up'], ffn_conv_prev, p['conv_w_ffn'], p['conv_b_ffn'])
    gate, val = jnp.split(up, 2, axis=-1)
    h = h + (jax.nn.silu(gate) * val) @ p['w_down']
    return h, k, v, ssd_state, ssd_conv, ffn_conv


def setup_inputs(seed: int = 0) -> dict:
    key = jax.random.key(seed)
    ks = jax.random.split(key, 26)
    f32 = jnp.float32

    def nrm(k, shape, scale):
        return scale * jax.random.normal(k, shape, f32)

    def gain(k, shape):
        return 1.0 + 0.01 * jax.random.normal(k, shape, f32)

    n_rows = N_META + PAST_LEN
    dt0 = jnp.exp(jax.random.uniform(ks[10], (DEPTH, SSD_HEADS), f32, math.log(1e-3), math.log(1e-1)))
    return {
        'x_prompt': nrm(ks[0], (BATCH, SEQ, D_MODEL), 1.0),
        'x_sample': nrm(ks[1], (DEC_BATCH, DEC_SEQ, D_MODEL), 1.0),
        'cache_k': nrm(ks[2], (DEPTH, DEC_BATCH, n_rows, SB_HEADS, SB_HEAD_DIM), 1.0),
        'cache_v': nrm(ks[3], (DEPTH, DEC_BATCH, n_rows, SB_HEADS, SB_HEAD_DIM), 1.0),
        'state_ssm': nrm(ks[4], (DEPTH, DEC_BATCH, SSD_HEADS, SSD_HEAD_DIM, SSD_STATE), 0.1),
        'state_ssm_conv': nrm(ks[5], (DEPTH, DEC_BATCH, SSD_CONV - 1, SSD_CONV_CH), 1.0),
        'state_ffn_conv': nrm(ks[6], (DEPTH, DEC_BATCH, FFN_CONV - 1, 2 * D_FF), 1.0),
        'meta_tokens': nrm(ks[7], (N_META, D_MODEL), 1.0),
        'g_mix': gain(ks[8], (DEPTH, D_MODEL)),
        'w_in': nrm(ks[9], (DEPTH, D_MODEL, IN_COLS), D_MODEL ** -0.5),
        'conv_w_ssd': nrm(ks[11], (DEPTH, SSD_CONV, SSD_CONV_CH), SSD_CONV ** -0.5),
        'conv_b_ssd': nrm(ks[12], (DEPTH, SSD_CONV_CH), 0.02),
        'dt_bias': dt0 + jnp.log(-jnp.expm1(-dt0)),
        'a_log': jnp.log(jax.random.uniform(ks[13], (DEPTH, SSD_HEADS), f32, 1.0, 16.0)),
        'd_skip': 1.0 + 0.1 * jax.random.normal(ks[14], (DEPTH, SSD_HEADS), f32),
        'g_ssd_norm': gain(ks[15], (DEPTH, SSD_WIDTH)),
        'w_br_att': nrm(ks[16], (DEPTH, SB_WIDTH, D_MODEL), SB_WIDTH ** -0.5),
        'w_br_ssd': nrm(ks[17], (DEPTH, SSD_WIDTH, D_MODEL), SSD_WIDTH ** -0.5),
        'w_out': nrm(ks[18], (DEPTH, D_MODEL, D_MODEL), D_MODEL ** -0.5),
        'g_ffn': gain(ks[19], (DEPTH, D_MODEL)),
        'w_up': nrm(ks[20], (DEPTH, D_MODEL, 2 * D_FF), D_MODEL ** -0.5),
        'conv_w_ffn': nrm(ks[21], (DEPTH, FFN_CONV, 2 * D_FF), FFN_CONV ** -0.5),
        'conv_b_ffn': nrm(ks[22], (DEPTH, 2 * D_FF), 0.02),
        'w_down': nrm(ks[23], (DEPTH, D_FF, D_MODEL), D_FF ** -0.5),
        'g_final': gain(ks[24], (D_MODEL,)),
    }


def reference(x_prompt, x_sample, cache_k, cache_v, state_ssm, state_ssm_conv, state_ffn_conv, meta_tokens,
              g_mix, w_in, conv_w_ssd, conv_b_ssd, dt_bias, a_log, d_skip, g_ssd_norm, w_br_att, w_br_ssd,
              w_out, g_ffn, w_up, conv_w_ffn, conv_b_ffn, w_down, g_final):
    bp, bs = x_prompt.shape[0], x_sample.shape[0]
    dtype = x_prompt.dtype
    meta = jnp.broadcast_to(meta_tokens.astype(dtype)[None], (bp, N_META, D_MODEL))
    hp = jnp.concatenate([meta, x_prompt], axis=1)
    hs = x_sample
    meta_pad = (-N_META) % CHUNK
    kp_l, vp_l, sp_l, cp_l, fp_l = [], [], [], [], []
    ks_l, vs_l, ss_l, cs_l, fs_l = [], [], [], [], []
    for l in range(DEPTH):
        p = {'g_mix': g_mix[l], 'w_in': w_in[l], 'conv_w_ssd': conv_w_ssd[l], 'conv_b_ssd': conv_b_ssd[l],
             'dt_bias': dt_bias[l], 'a_log': a_log[l], 'd_skip': d_skip[l], 'g_ssd_norm': g_ssd_norm[l],
             'w_br_att': w_br_att[l], 'w_br_ssd': w_br_ssd[l], 'w_out': w_out[l], 'g_ffn': g_ffn[l],
             'w_up': w_up[l], 'conv_w_ffn': conv_w_ffn[l], 'conv_b_ffn': conv_b_ffn[l], 'w_down': w_down[l]}
        hp, kp, vp, sp, cp, fp = trunk_layer(
            hp, p, None,
            jnp.zeros((bp, SSD_HEADS, SSD_HEAD_DIM, SSD_STATE), dtype),
            jnp.zeros((bp, SSD_CONV - 1, SSD_CONV_CH), dtype),
            jnp.zeros((bp, FFN_CONV - 1, 2 * D_FF), dtype),
            meta_pad)
        hs, ks_, vs_, ss, cs, fs = trunk_layer(
            hs, p, (cache_k[l], cache_v[l]), state_ssm[l], state_ssm_conv[l], state_ffn_conv[l], 0)
        kp_l.append(kp); vp_l.append(vp); sp_l.append(sp); cp_l.append(cp); fp_l.append(fp)
        ks_l.append(ks_); vs_l.append(vs_); ss_l.append(ss); cs_l.append(cs); fs_l.append(fs)
    y_prompt = rms_norm(hp, g_final)[:, N_META:]
    y_sample = rms_norm(hs, g_final)
    return (y_prompt, y_sample,
            jnp.stack(kp_l), jnp.stack(vp_l), jnp.stack(sp_l), jnp.stack(cp_l), jnp.stack(fp_l),
            jnp.stack(ks_l), jnp.stack(vs_l), jnp.stack(ss_l), jnp.stack(cs_l), jnp.stack(fs_l))
```

```cpp
#define SINGLE_LAUNCH 1
#define GEMM8 1
#define SKIP_ATT 0
#define NPH 13
#include <hip/hip_runtime.h>
#include <hip/hip_cooperative_groups.h>
#include <cstdio>
#include <cstdint>
namespace cg = cooperative_groups;

typedef unsigned short bf16_t;
typedef short bf16x8 __attribute__((ext_vector_type(8)));
typedef float f32x4 __attribute__((ext_vector_type(4)));
typedef unsigned u32x4 __attribute__((ext_vector_type(4)));
typedef unsigned u32x2 __attribute__((ext_vector_type(2)));

constexpr int DM = 1024, NBP = 4, SEQ = 4096, LP = 4112, NP = NBP * LP  , NBS = 32, LS = 16, NS = NBS * LS  ;
constexpr int MR = NP + NS  , PAST = 1040;
constexpr int NCH_P = 65, NGC = NBP * NCH_P + NBS  ;
constexpr int DFF = 2816, DFF2 = 5632, XBC = 3072, SSDW = 2048;
constexpr int NA = 6400  , NB1 = 4096  ;
constexpr float EPS = 1e-6f;
constexpr int NTHR = 512;
constexpr int SMEM_BYTES = 131072;

constexpr size_t O_YP = 0;
constexpr size_t O_YS = O_YP + (size_t)NBP * SEQ * DM;
constexpr size_t O_KP = O_YS + (size_t)NS * DM;
constexpr size_t O_VP = O_KP + (size_t)NP * DM;
constexpr size_t O_SSMP = O_VP + (size_t)NP * DM;
constexpr size_t O_SCP = O_SSMP + (size_t)NBP * 32 * 64 * 128;
constexpr size_t O_FCP = O_SCP + (size_t)NBP * 3 * XBC;
constexpr size_t O_KS = O_FCP + (size_t)NBP * 2 * DFF2;
constexpr size_t O_VS = O_KS + (size_t)NS * DM;
constexpr size_t O_SSMS = O_VS + (size_t)NS * DM;
constexpr size_t O_SCS = O_SSMS + (size_t)NBS * 32 * 64 * 128;
constexpr size_t O_FCS = O_SCS + (size_t)NBS * 3 * XBC;
constexpr size_t O_END = O_FCS + (size_t)NBS * 2 * DFF2;

constexpr size_t al(size_t x) { return (x + 255) & ~(size_t)255; }
constexpr size_t SZ1K = (size_t)MR * 1024 * 2;
constexpr size_t W_WTA = 0;
constexpr size_t W_WTB = W_WTA + (size_t)NA * 1024 * 2;
constexpr size_t W_WA = W_WTB + (size_t)NB1 * 1024 * 2;
constexpr size_t W_WS = W_WA + (size_t)1024 * 1024 * 2;
constexpr size_t W_WO = W_WS + (size_t)1024 * 2048 * 2;
constexpr size_t W_WUP = W_WO + (size_t)1024 * 1024 * 2;
constexpr size_t W_WDN = W_WUP + (size_t)DFF2 * 1024 * 2;
constexpr size_t W_SMALL = W_WDN + (size_t)1024 * DFF * 2;
constexpr size_t W_RSQ1 = W_SMALL;
constexpr size_t W_RSQ2 = W_RSQ1 + al((size_t)MR * 4);
constexpr size_t W_DEC = W_RSQ2 + al((size_t)MR * 4);
constexpr size_t W_BAR = W_DEC + al((size_t)NGC * 32 * 4);
constexpr size_t W_A = W_BAR + 4096;
constexpr size_t W_UB = W_A;
constexpr size_t W_XPRE = W_UB + SZ1K;
constexpr size_t W_DT = W_XPRE + 3 * SZ1K;
constexpr size_t W_C = W_DT + al((size_t)MR * 32 * 4);
constexpr size_t W_QB = W_C;
constexpr size_t W_KB = W_QB + SZ1K;
constexpr size_t W_VB = W_KB + SZ1K;
constexpr size_t W_CS = W_VB + SZ1K;
constexpr size_t SZ_CS = (size_t)NGC * 32 * 8192 * 2;
constexpr size_t W_D = W_CS + al(SZ_CS);
constexpr size_t W_END = W_D + (size_t)(MR + 256) * DFF * 2;
constexpr size_t W_YSSD = W_KB;
constexpr size_t W_ZB = W_XPRE;
constexpr size_t W_MB = W_XPRE + 2 * SZ1K;
constexpr size_t W_GB = W_CS;
constexpr size_t W_MTMP = W_CS + 2 * SZ1K;
constexpr size_t W_H1F = W_A;
constexpr size_t W_H1B = W_A + 2 * SZ1K;
constexpr size_t W_UPB = W_C;
constexpr size_t W_ACT = W_D;
constexpr size_t W_ATT = W_D;
static_assert(W_MTMP + 2 * SZ1K <= W_CS + SZ_CS, "mtmp fits");
static_assert((size_t)MR * DFF2 * 2 <= (W_D - W_C), "upb fits");
static_assert(W_END <= (size_t)545259520, "workspace");

struct P {
    const float *x_prompt, *x_sample, *cache_k, *cache_v, *state_ssm, *state_ssm_conv, *state_ffn_conv, *meta, *g_mix, *w_in,
        *conv_w_ssd, *conv_b_ssd, *dt_bias, *a_log, *d_skip, *g_ssd_norm, *w_br_att, *w_br_ssd, *w_out, *g_ffn, *w_up,
        *conv_w_ffn, *conv_b_ffn, *w_down, *g_final;
    float* out;
    char* ws;
};

extern __shared__ __attribute__((aligned(16))) char smem[];

typedef __bf16 bf16x2_t __attribute__((ext_vector_type(2)));
typedef float f32x2_t __attribute__((ext_vector_type(2)));
__device__ __forceinline__ unsigned pk2(float lo, float hi) { f32x2_t v = {lo, hi}; bf16x2_t b = __builtin_convertvector(v, bf16x2_t); return __builtin_bit_cast(unsigned, b); }
__device__ __forceinline__ bf16_t f2bf(float f) { return (bf16_t)(pk2(f, 0.f) & 0xffffu); }
__device__ __forceinline__ float bf2f(bf16_t b) { return __uint_as_float(((unsigned)b) << 16); }
__device__ __forceinline__ float bflo(unsigned u) { return __uint_as_float(u << 16); }
__device__ __forceinline__ float bfhi(unsigned u) { return __uint_as_float(u & 0xffff0000u); }
__device__ __forceinline__ void unpack8(u32x4 v, float (&o)[8]) {
    o[0] = bflo(v.x); o[1] = bfhi(v.x); o[2] = bflo(v.y); o[3] = bfhi(v.y); o[4] = bflo(v.z); o[5] = bfhi(v.z); o[6] = bflo(v.w); o[7] = bfhi(v.w);
}
__device__ __forceinline__ u32x4 pack8(const float (&o)[8]) { u32x4 v; v.x = pk2(o[0], o[1]); v.y = pk2(o[2], o[3]); v.z = pk2(o[4], o[5]); v.w = pk2(o[6], o[7]); return v; }
__device__ __forceinline__ float softplus_f(float z) { return fmaxf(z, 0.f) + __logf(1.f + __expf(-fabsf(z))); }
__device__ __forceinline__ float silu_f(float x) { return x * __builtin_amdgcn_rcpf(1.f + __expf(-x)); }
__device__ __forceinline__ float sigmoid_f(float x) { return __builtin_amdgcn_rcpf(1.f + __expf(-x)); }
__device__ __forceinline__ float wave_sum(float v) {
#pragma unroll
    for (int o = 32; o > 0; o >>= 1) v += __shfl_xor(v, o);
    return v;
}
__device__ __forceinline__ const float* hrow(const P& p, int row) {
    if (row < NP) { int b = row / LP, t = row - b * LP; return t < 16 ? p.meta + (size_t)t * DM : p.x_prompt + ((size_t)b * SEQ + (t - 16)) * DM; }
    return p.x_sample + (size_t)(row - NP) * DM;
}

constexpr int BM = 256, BK = 64, HALF = 128, HT = HALF * BK;
__device__ __forceinline__ int lds_byte(int r, int c) { int st = (r >> 4) * 2 + (c >> 5), rr = r & 15, cc = c & 31, ob = rr * 64 + cc * 2; return st * 1024 + (ob ^ (((ob >> 9) & 1) << 5)); }
__device__ __forceinline__ void stage_rc(int b, int& R, int& C) { int st = b / 1024, sb = b % 1024, swz = sb ^ (((sb >> 9) & 1) << 5); R = (st >> 1) * 16 + swz / 64; C = (st & 1) * 32 + (swz % 64) / 2; }

#define SHMB ((bf16_t*)smem)
#define SA(b, h) (SHMB + ((b) * 2 + (h)) * HT)
#define SB(b, h) (SHMB + (4 + (b) * 2 + (h)) * HT)
#define STAGE(Pp, BASE, br, kt, KK) do { size_t _g = (size_t)(br) * (KK) + (size_t)(kt) * BK; \
    for (int _i = 0; _i < 2; ++_i) { int _b = threadIdx.x * 16 + _i * 8192; int _r, _c; stage_rc(_b, _r, _c); \
      __builtin_amdgcn_global_load_lds((const unsigned*)((BASE) + _g + (size_t)_r * (KK) + _c), (unsigned*)((char*)(Pp) + _b), 16, 0, 0); } } while (0)
#define LDA(dst, b, h) for (int m = 0; m < 4; ++m) for (int k = 0; k < 2; ++k) \
    dst[m][k] = *reinterpret_cast<const bf16x8*>((char*)SA(b, h) + lds_byte(wr * 64 + m * 16 + fr, k * 32 + fq * 8))
#define LDB(dst, b, h) for (int n = 0; n < 2; ++n) for (int k = 0; k < 2; ++k) \
    dst[n][k] = *reinterpret_cast<const bf16x8*>((char*)SB(b, h) + lds_byte(wc * 32 + n * 16 + fr, k * 32 + fq * 8))
#define MMA(ai, bj, At, Bt) do { __builtin_amdgcn_s_setprio(1); \
    for (int m = 0; m < 4; ++m) for (int n = 0; n < 2; ++n) for (int k = 0; k < 2; ++k) \
      acc[ai][bj][m][n] = __builtin_amdgcn_mfma_f32_16x16x32_bf16(Bt[n][k], At[m][k], acc[ai][bj][m][n], 0, 0, 0); \
    __builtin_amdgcn_s_setprio(0); } while (0)
#define WAIT_V(n) asm volatile("s_waitcnt vmcnt(" #n ")" ::: "memory")
#define WAIT_L(n) asm volatile("s_waitcnt lgkmcnt(" #n ")" ::: "memory")
#define BAR __builtin_amdgcn_s_barrier()

__device__ __forceinline__ void gemm_tile(const bf16_t* __restrict__ A, const bf16_t* __restrict__ Bt, int K, int brow, int bcol, f32x4 (&acc)[2][2][4][2]) {
    const int wid = threadIdx.x >> 6, lane = threadIdx.x & 63, wr = wid >> 2, wc = wid & 3, fr = lane & 15, fq = lane >> 4;
    const int nt = K / BK;
    int so[2];
#pragma unroll
    for (int i = 0; i < 2; ++i) { int r_, c_; stage_rc(threadIdx.x * 16 + i * 8192, r_, c_); so[i] = r_ * K + c_; }
    const bf16_t* Ab = A + (size_t)brow * K; const bf16_t* Bb = Bt + (size_t)bcol * K;
    const int hk = HALF * K;
    char* ldst = smem + threadIdx.x * 16;
#define STG(bufbyte, base, koff) do { \
        __builtin_amdgcn_global_load_lds((const unsigned*)((base) + (koff) + so[0]), (unsigned*)(ldst + (bufbyte)), 16, 0, 0); \
        __builtin_amdgcn_global_load_lds((const unsigned*)((base) + (koff) + so[1]), (unsigned*)(ldst + (bufbyte) + 8192), 16, 0, 0); } while (0)
#define STG_TILE(b, kt) do { const int ko_ = (kt) * BK; \
        STG((4 + (b) * 2 + 0) * 16384, Bb, ko_); STG(((b) * 2 + 0) * 16384, Ab, ko_); \
        STG((4 + (b) * 2 + 1) * 16384, Bb + hk, ko_); STG(((b) * 2 + 1) * 16384, Ab + hk, ko_); } while (0)
    const int sw = (fr * 64 + fq * 16) ^ (((fr >> 3) & 1) << 5);
    const char* la = smem + wr * 8192 + sw;
    const char* lb = smem + 65536 + wc * 4096 + sw;
#define LDA2(dst, b, h) _Pragma("unroll") for (int m = 0; m < 4; ++m) _Pragma("unroll") for (int k = 0; k < 2; ++k) \
        dst[m][k] = *reinterpret_cast<const bf16x8*>(la + ((b) * 2 + (h)) * 16384 + m * 2048 + k * 1024)
#define LDB2(dst, b, h) _Pragma("unroll") for (int n = 0; n < 2; ++n) _Pragma("unroll") for (int k = 0; k < 2; ++k) \
        dst[n][k] = *reinterpret_cast<const bf16x8*>(lb + ((b) * 2 + (h)) * 16384 + n * 2048 + k * 1024)
#define KTILE(b) do { bf16x8 At[4][2], B0[2][2]; \
        LDA2(At, b, 0); LDB2(B0, b, 0); MMA(0, 0, At, B0); LDB2(B0, b, 1); MMA(0, 1, At, B0); \
        LDA2(At, b, 1); MMA(1, 1, At, B0); LDB2(B0, b, 0); MMA(1, 0, At, B0); } while (0)
#if GEMM8
#define STH(bufidx, base, kt) STG((bufidx) * 16384, base, (kt) * BK)
#define SAi(b, h) ((b) * 2 + (h))
#define SBi(b, h) (4 + (b) * 2 + (h))
#define SCHED __builtin_amdgcn_sched_barrier(0)
    {
        bf16x8 At[4][2], B0[2][2], B1[2][2];
        STH(SBi(0, 0), Bb, 0); STH(SAi(0, 0), Ab, 0); STH(SBi(0, 1), Bb + hk, 0); STH(SAi(0, 1), Ab + hk, 0);
        if (wr == 1) BAR;
        WAIT_V(4); BAR;
        STH(SBi(1, 0), Bb, 1); STH(SAi(1, 0), Ab, 1); STH(SBi(1, 1), Bb + hk, 1);
        WAIT_V(6); BAR;
        for (int t = 0; t < nt - 2; t += 2) {
            LDB2(B0, 0, 0); SCHED; LDA2(At, 0, 0); STH(SAi(1, 1), Ab + hk, t + 1);
            WAIT_L(8); BAR; WAIT_L(0); MMA(0, 0, At, B0); BAR; SCHED;
            LDB2(B1, 0, 1); STH(SBi(0, 0), Bb, t + 2);
            BAR; WAIT_L(0); MMA(0, 1, At, B1); BAR;
            LDA2(At, 0, 1); STH(SAi(0, 0), Ab, t + 2);
            BAR; WAIT_L(0); MMA(1, 0, At, B0); BAR; SCHED;
            STH(SBi(0, 1), Bb + hk, t + 2);
            WAIT_V(6); BAR; MMA(1, 1, At, B1); BAR;
            LDB2(B0, 1, 0); SCHED; LDA2(At, 1, 0); STH(SAi(0, 1), Ab + hk, t + 2);
            WAIT_L(8); BAR; WAIT_L(0); MMA(0, 0, At, B0); BAR; SCHED;
            LDB2(B1, 1, 1); STH(SBi(1, 0), Bb, t + 3);
            BAR; WAIT_L(0); MMA(0, 1, At, B1); BAR;
            LDA2(At, 1, 1); STH(SAi(1, 0), Ab, t + 3);
            BAR; WAIT_L(0); MMA(1, 0, At, B0); BAR; SCHED;
            STH(SBi(1, 1), Bb + hk, t + 3);
            WAIT_V(6); BAR; MMA(1, 1, At, B1); BAR;
        }
        { LDB2(B0, 0, 0); LDA2(At, 0, 0); STH(SAi(1, 1), Ab + hk, nt - 1);
          BAR; WAIT_L(0); MMA(0, 0, At, B0); BAR;
          LDB2(B1, 0, 1); BAR; WAIT_L(0); MMA(0, 1, At, B1); BAR;
          LDA2(At, 0, 1); WAIT_V(4); BAR; WAIT_L(0); MMA(1, 0, At, B0); MMA(1, 1, At, B1); BAR; }
        { LDB2(B0, 1, 0); LDA2(At, 1, 0); WAIT_V(2); BAR; WAIT_L(0); MMA(0, 0, At, B0); BAR;
          LDB2(B1, 1, 1); WAIT_V(0); BAR; WAIT_L(0); MMA(0, 1, At, B1); BAR;
          LDA2(At, 1, 1); BAR; WAIT_L(0); MMA(1, 0, At, B0); MMA(1, 1, At, B1); BAR; }
        if (wr == 0) BAR;
    }
#else
    STG_TILE(0, 0);
    for (int t = 0; t < nt; t += 2) {
        STG_TILE(1, t + 1);
        WAIT_V(8); BAR;
        KTILE(0);
        WAIT_L(0); BAR;
        if (t + 2 < nt) { STG_TILE(0, t + 2); WAIT_V(8); } else { WAIT_V(0); }
        BAR;
        KTILE(1);
        WAIT_L(0); BAR;
    }
#endif
}

__device__ __forceinline__ bool tile_next(int L, int nM, int nN, int& pm, int& pn) {
    const int nwg = nM * nN; if (L >= nwg) return false;
    int wgid = L; { const int q = nwg / 8, r = nwg % 8, xcd = wgid % 8, off = wgid / 8; wgid = (xcd < r ? xcd * (q + 1) : r * (q + 1) + (xcd - r) * q) + off; }
    const int WGM = 8, nig = WGM * nN, gid = wgid / nig, fm = gid * WGM, gsz = (nM - fm) < WGM ? (nM - fm) : WGM;
    pm = fm + ((wgid % nig) % gsz); pn = (wgid % nig) / gsz; return true;
}

#define ACC_FOREACH(...) do { \
    _Pragma("unroll") for (int ai = 0; ai < 2; ++ai) _Pragma("unroll") for (int m = 0; m < 4; ++m) { \
      const int row = brow + ai * HALF + wr * 64 + m * 16 + fr; if (row < MR) { \
      _Pragma("unroll") for (int bj = 0; bj < 2; ++bj) _Pragma("unroll") for (int n = 0; n < 2; ++n) { \
        const int col = bcol + bj * HALF + wc * 32 + n * 16 + fq * 4; f32x4 v = acc[ai][bj][m][n]; __VA_ARGS__ } } __builtin_amdgcn_sched_barrier(0); } } while (0)

#define GEMM_IDS const int wid = threadIdx.x >> 6, lane = threadIdx.x & 63, wr = wid >> 2, wc = wid & 3, fr = lane & 15, fq = lane >> 4; (void)wid; (void)lane
#define ZERO_ACC f32x4 acc[2][2][4][2]; _Pragma("unroll") for (int a_ = 0; a_ < 2; ++a_) _Pragma("unroll") for (int b_ = 0; b_ < 2; ++b_) _Pragma("unroll") for (int c_ = 0; c_ < 4; ++c_) _Pragma("unroll") for (int d_ = 0; d_ < 2; ++d_) acc[a_][b_][c_][d_] = (f32x4){0.f, 0.f, 0.f, 0.f}

__device__ __forceinline__ void st_bf4(bf16_t* p, f32x4 v) { u32x2 w; w.x = pk2(v[0], v[1]); w.y = pk2(v[2], v[3]); *(u32x2*)p = w; }

__device__ __forceinline__ void gemm_qtile(const bf16_t* __restrict__ A, const bf16_t* __restrict__ Bt, int K, int brow, int bcol, f32x4 (&accq)[4][2]) {
    const int wid = threadIdx.x >> 6, lane = threadIdx.x & 63, fr = lane & 15, fq = lane >> 4;
    const int nt = K / BK;
    int so[2];
#pragma unroll
    for (int i = 0; i < 2; ++i) { int r_, c_; stage_rc(threadIdx.x * 16 + i * 8192, r_, c_); so[i] = r_ * K + c_; }
    const bf16_t* Ab = A + (size_t)brow * K; const bf16_t* Bb = Bt + (size_t)bcol * K;
    const int hk = HALF * K;
    char* ldst = smem + threadIdx.x * 16;
#define QSTG_TILE(b, kt) do { const int ko_ = (kt) * BK; \
        __builtin_amdgcn_global_load_lds((const unsigned*)(Ab + ko_ + so[0]), (unsigned*)(ldst + ((b) * 2) * 16384), 16, 0, 0); \
        STG((4 + (b) * 2 + 0) * 16384, Bb, ko_); STG((4 + (b) * 2 + 1) * 16384, Bb + hk, ko_); } while (0)
    const int sw = (fr * 64 + fq * 16) ^ (((fr >> 3) & 1) << 5);
    const char* la = smem + sw;
    const char* lb = smem + 65536 + (wid >> 2) * 16384 + (wid & 3) * 4096 + sw;
#define QKTILE(b) do { bf16x8 At[4][2], Bq[2][2]; \
        _Pragma("unroll") for (int m = 0; m < 4; ++m) _Pragma("unroll") for (int k = 0; k < 2; ++k) At[m][k] = *reinterpret_cast<const bf16x8*>(la + ((b) * 2) * 16384 + m * 2048 + k * 1024); \
        _Pragma("unroll") for (int n = 0; n < 2; ++n) _Pragma("unroll") for (int k = 0; k < 2; ++k) Bq[n][k] = *reinterpret_cast<const bf16x8*>(lb + ((b) * 2) * 16384 + n * 2048 + k * 1024); \
        _Pragma("unroll") for (int m = 0; m < 4; ++m) _Pragma("unroll") for (int n = 0; n < 2; ++n) _Pragma("unroll") for (int k = 0; k < 2; ++k) \
            accq[m][n] = __builtin_amdgcn_mfma_f32_16x16x32_bf16(Bq[n][k], At[m][k], accq[m][n], 0, 0, 0); } while (0)
    QSTG_TILE(0, 0);
    for (int t = 0; t < nt; t += 2) {
        QSTG_TILE(1, t + 1);
        WAIT_V(5); BAR;
        QKTILE(0);
        WAIT_L(0); BAR;
        if (t + 2 < nt) { QSTG_TILE(0, t + 2); WAIT_V(5); } else { WAIT_V(0); }
        BAR;
        QKTILE(1);
        WAIT_L(0); BAR;
    }
}

template <class Epi>
__device__ __forceinline__ void gemm_phase(const bf16_t* __restrict__ A, const bf16_t* __restrict__ Bt, int K, int N, const Epi& epi) {
    GEMM_IDS;
    const int nM = (MR + BM - 1) / BM, nN = N / BM, T = nM * nN;
    int F = (T / (int)gridDim.x) * (int)gridDim.x;
    if (T - F > 64) F = T;
    int pm, pn;
    for (int L = blockIdx.x; L < F; L += gridDim.x) {
        tile_next(L, nM, nN, pm, pn);
        const int brow = pm * BM, bcol = pn * BM;
        ZERO_ACC;
        gemm_tile(A, Bt, K, brow, bcol, acc);
#pragma unroll
        for (int ai = 0; ai < 2; ++ai)
#pragma unroll
            for (int m = 0; m < 4; ++m) {
                const int row = brow + ai * HALF + wr * 64 + m * 16 + fr;
                float ss = 0.f;
                if (row < MR) {
#pragma unroll
                    for (int bj = 0; bj < 2; ++bj)
#pragma unroll
                        for (int n = 0; n < 2; ++n) epi.frag(row, bcol + bj * HALF + wc * 32 + n * 16 + fq * 4, acc[ai][bj][m][n], ss);
                }
                if (Epi::ROWSUM) { ss += __shfl_xor(ss, 16); ss += __shfl_xor(ss, 32); if (fq == 0 && row < MR) epi.row_done(row, ss); }
                __builtin_amdgcn_sched_barrier(0);
            }
    }
    __builtin_amdgcn_sched_barrier(0);
    for (int q = blockIdx.x; q < 4 * (T - F); q += gridDim.x) {
        tile_next(F + (q >> 2), nM, nN, pm, pn);
        const int brow = pm * BM + (q & 3) * 64, bcol = pn * BM;
        if (brow >= MR) continue;
        f32x4 accq[4][2];
#pragma unroll
        for (int m = 0; m < 4; ++m) { accq[m][0] = (f32x4){0.f, 0.f, 0.f, 0.f}; accq[m][1] = (f32x4){0.f, 0.f, 0.f, 0.f}; }
        gemm_qtile(A, Bt, K, brow, bcol, accq);
#pragma unroll
        for (int m = 0; m < 4; ++m) {
            const int row = brow + m * 16 + fr;
            float ss = 0.f;
            if (row < MR) {
#pragma unroll
                for (int n = 0; n < 2; ++n) epi.frag(row, bcol + (wid >> 2) * HALF + (wid & 3) * 32 + n * 16 + fq * 4, accq[m][n], ss);
            }
            if (Epi::ROWSUM) { ss += __shfl_xor(ss, 16); ss += __shfl_xor(ss, 32); if (fq == 0 && row < MR) epi.row_done(row, ss); }
            __builtin_amdgcn_sched_barrier(0);
        }
    }
}

__device__ __forceinline__ void phase_gemm1a(const P& p) {
    GEMM_IDS;
    const bf16_t* ub = (const bf16_t*)(p.ws + W_UB); const bf16_t* wt = (const bf16_t*)(p.ws + W_WTA);
    bf16_t* qb = (bf16_t*)(p.ws + W_QB); bf16_t* kb = (bf16_t*)(p.ws + W_KB); bf16_t* vb = (bf16_t*)(p.ws + W_VB);
    bf16_t* xpre = (bf16_t*)(p.ws + W_XPRE); float* dtr = (float*)(p.ws + W_DT);
    const int nM = (MR + BM - 1) / BM, nN = NA / BM;
    int pm, pn;
    for (int L = blockIdx.x; tile_next(L, nM, nN, pm, pn); L += gridDim.x) {
        const int brow = pm * BM, bcol = pn * BM;
        ZERO_ACC;
        gemm_tile(ub, wt, 1024, brow, bcol, acc);
        if (bcol < 1024) {
            ACC_FOREACH({ st_bf4(qb + (size_t)row * 1024 + col, v * 0.125f); });
        } else if (bcol < 3072) {
            const bool isk = bcol < 2048;
            bf16_t* dstb = isk ? kb : vb; const int c0 = isk ? 1024 : 2048;
            ACC_FOREACH({ const int c = col - c0; st_bf4(dstb + (size_t)row * 1024 + c, v);
                float* o = p.out + (row < NP ? (isk ? O_KP : O_VP) + (size_t)row * 1024 : (isk ? O_KS : O_VS) + (size_t)(row - NP) * 1024) + c; *(f32x4*)o = v; });
        } else if (bcol < 6144) {
            ACC_FOREACH({ const int c = col - 3072; st_bf4(xpre + (size_t)row * XBC + c, v);
                if (row < NP) { const int b = row / LP, t = row - b * LP; if (t >= LP - 3) *(f32x4*)(p.out + O_SCP + ((size_t)b * 3 + (t - (LP - 3))) * XBC + c) = v; }
                else { const int r2 = row - NP, b = r2 >> 4, t = r2 & 15; if (t >= LS - 3) *(f32x4*)(p.out + O_SCS + ((size_t)b * 3 + (t - (LS - 3))) * XBC + c) = v; } });
        } else {
            ACC_FOREACH({ const int c = col - 6144; if (c < 32) *(f32x4*)(dtr + (size_t)row * 32 + c) = v; });
        }
    }
}

struct Epi1b { static constexpr bool ROWSUM = false; bf16_t* zb; bf16_t* gb;
    __device__ __forceinline__ void frag(int row, int col, f32x4 v, float&) const {
        const bool isz = col < 2048;
        f32x4 s; s[0] = isz ? v[0] : sigmoid_f(v[0]); s[1] = isz ? v[1] : sigmoid_f(v[1]); s[2] = isz ? v[2] : sigmoid_f(v[2]); s[3] = isz ? v[3] : sigmoid_f(v[3]);
        st_bf4((isz ? zb : gb) + (size_t)row * 2048 + (isz ? col : col - 2048), s); }
    __device__ __forceinline__ void row_done(int, float) const {} };
__device__ __forceinline__ void phase_gemm1b(const P& p) {
    Epi1b e{(bf16_t*)(p.ws + W_ZB), (bf16_t*)(p.ws + W_GB)};
    gemm_phase((const bf16_t*)(p.ws + W_UB), (const bf16_t*)(p.ws + W_WTB), 1024, NB1, e);
}

struct Epi2a { static constexpr bool ROWSUM = false; const bf16_t* gb; bf16_t* mtmp;
    __device__ __forceinline__ void frag(int row, int col, f32x4 v, float&) const {
        u32x2 g = *(const u32x2*)(gb + (size_t)row * 2048 + col);
        f32x4 o; o[0] = v[0] * bflo(g.x); o[1] = v[1] * bfhi(g.x); o[2] = v[2] * bflo(g.y); o[3] = v[3] * bfhi(g.y);
        st_bf4(mtmp + (size_t)row * 1024 + col, o); }
    __device__ __forceinline__ void row_done(int, float) const {} };
struct Epi2b { static constexpr bool ROWSUM = false; const bf16_t* gb; const bf16_t* mtmp; bf16_t* mb;
    __device__ __forceinline__ void frag(int row, int col, f32x4 v, float&) const {
        u32x2 g = *(const u32x2*)(gb + (size_t)row * 2048 + 1024 + col);
        u32x2 mt = *(const u32x2*)(mtmp + (size_t)row * 1024 + col);
        f32x4 o; o[0] = bflo(mt.x) + v[0] * bflo(g.x); o[1] = bfhi(mt.x) + v[1] * bfhi(g.x); o[2] = bflo(mt.y) + v[2] * bflo(g.y); o[3] = bfhi(mt.y) + v[3] * bfhi(g.y);
        st_bf4(mb + (size_t)row * 1024 + col, o); }
    __device__ __forceinline__ void row_done(int, float) const {} };
__device__ __forceinline__ void phase_gemm2(const P& p) {
    Epi2a ea{(const bf16_t*)(p.ws + W_GB), (bf16_t*)(p.ws + W_MTMP)};
    gemm_phase((const bf16_t*)(p.ws + W_ATT), (const bf16_t*)(p.ws + W_WA), 1024, 1024, ea);
    __builtin_amdgcn_sched_barrier(0);
    Epi2b eb{(const bf16_t*)(p.ws + W_GB), (const bf16_t*)(p.ws + W_MTMP), (bf16_t*)(p.ws + W_MB)};
    gemm_phase((const bf16_t*)(p.ws + W_YSSD), (const bf16_t*)(p.ws + W_WS), 2048, 1024, eb);
}

struct Epi3 { static constexpr bool ROWSUM = true; const P* pp; float* h1f; bf16_t* h1b; float* rsq;
    __device__ __forceinline__ void frag(int row, int col, f32x4 a, float& ss) const {
        f32x4 v = a + *(const f32x4*)(hrow(*pp, row) + col);
        *(f32x4*)(h1f + (size_t)row * 1024 + col) = v; st_bf4(h1b + (size_t)row * 1024 + col, v);
        ss += v[0] * v[0] + v[1] * v[1] + v[2] * v[2] + v[3] * v[3]; }
    __device__ __forceinline__ void row_done(int row, float ss) const { atomicAdd(rsq + row, ss); } };
__device__ __forceinline__ void phase_gemm3(const P& p) {
    Epi3 e{&p, (float*)(p.ws + W_H1F), (bf16_t*)(p.ws + W_H1B), (float*)(p.ws + W_RSQ1)};
    gemm_phase((const bf16_t*)(p.ws + W_MB), (const bf16_t*)(p.ws + W_WO), 1024, 1024, e);
}

__device__ __forceinline__ void phase_gemm4(const P& p) {
    GEMM_IDS;
    const bf16_t* h1b = (const bf16_t*)(p.ws + W_H1B); const bf16_t* wup = (const bf16_t*)(p.ws + W_WUP);
    bf16_t* upb = (bf16_t*)(p.ws + W_UPB); const float* rsq = (const float*)(p.ws + W_RSQ1);
    const int nM = (MR + BM - 1) / BM, nN = DFF2 / BM;
    int pm, pn;
    for (int L = blockIdx.x; tile_next(L, nM, nN, pm, pn); L += gridDim.x) {
        const int brow = pm * BM, bcol = pn * BM;
        ZERO_ACC;
        gemm_tile(h1b, wup, 1024, brow, bcol, acc);
#pragma unroll
        for (int ai = 0; ai < 2; ++ai)
#pragma unroll
            for (int m = 0; m < 4; ++m) {
                const int row = brow + ai * HALF + wr * 64 + m * 16 + fr;
                if (row < MR) {
                    const float rinv = rsqrtf(__builtin_nontemporal_load(rsq + row) * (1.f / 1024.f) + EPS);
                    float* fo = nullptr;
                    if (row < NP) { const int b = row / LP, t = row - b * LP; if (t >= LP - 2) fo = p.out + O_FCP + ((size_t)b * 2 + (t - (LP - 2))) * DFF2; }
                    else { const int r2 = row - NP, b = r2 >> 4, t = r2 & 15; if (t >= LS - 2) fo = p.out + O_FCS + ((size_t)b * 2 + (t - (LS - 2))) * DFF2; }
#pragma unroll
                    for (int bj = 0; bj < 2; ++bj)
#pragma unroll
                        for (int n = 0; n < 2; ++n) {
                            const int col = bcol + bj * HALF + wc * 32 + n * 16 + fq * 4;
                            f32x4 v = acc[ai][bj][m][n] * rinv;
                            st_bf4(upb + (size_t)row * DFF2 + col, v);
                            if (fo) *(f32x4*)(fo + col) = v;
                        }
                }
                __builtin_amdgcn_sched_barrier(0);
            }
    }
}

struct Epi5 { static constexpr bool ROWSUM = true; const float* h1f; bf16_t* h2b; float* rsq;
    __device__ __forceinline__ void frag(int row, int col, f32x4 a, float& ss) const {
        f32x4 v = a + *(const f32x4*)(h1f + (size_t)row * 1024 + col); st_bf4(h2b + (size_t)row * 1024 + col, v);
        ss += v[0] * v[0] + v[1] * v[1] + v[2] * v[2] + v[3] * v[3]; }
    __device__ __forceinline__ void row_done(int row, float ss) const { atomicAdd(rsq + row, ss); } };
__device__ __forceinline__ void phase_gemm5(const P& p) {
    Epi5 e{(const float*)(p.ws + W_H1F), (bf16_t*)(p.ws + W_H1B), (float*)(p.ws + W_RSQ2)};
    gemm_phase((const bf16_t*)(p.ws + W_ACT), (const bf16_t*)(p.ws + W_WDN), DFF, 1024, e);
}

__device__ __forceinline__ void tr_tile(const float* __restrict__ src, int sstride, bf16_t* __restrict__ dst, int K, int n0, int k0, int mode, const float* __restrict__ scale) {
    float* tile = (float*)smem;
    const int tid = threadIdx.x;
    {
        const int kk = tid >> 6, n4 = (tid & 63) * 4;
        const int n = n0 + n4; int sc = n;
        if (mode == 1) sc = n < 3072 ? n : (n < 6176 ? n + 2048 : -1);
        else if (mode == 2) sc = n < 2048 ? n + 3072 : n + 6176;
        f32x4 v[8];
#pragma unroll
        for (int i = 0; i < 8; ++i) {
            const int k = kk + 8 * i;
            v[i] = (f32x4){0.f, 0.f, 0.f, 0.f};
            if (sc >= 0) v[i] = *(const f32x4*)(src + (size_t)(k0 + k) * sstride + sc);
            if (scale) v[i] = v[i] * scale[k0 + k];
        }
#pragma unroll
        for (int i = 0; i < 8; ++i) { const int k = kk + 8 * i;
            tile[k * 257 + n4 + 0] = v[i][0]; tile[k * 257 + n4 + 1] = v[i][1]; tile[k * 257 + n4 + 2] = v[i][2]; tile[k * 257 + n4 + 3] = v[i][3]; }
    }
    __syncthreads();
    {
        const int n = tid >> 1, k32 = (tid & 1) * 32;
#pragma unroll
        for (int q = 0; q < 4; ++q) {
            float o[8];
#pragma unroll
            for (int j = 0; j < 8; ++j) o[j] = tile[(k32 + q * 8 + j) * 257 + n];
            *(u32x4*)(dst + (size_t)(n0 + n) * K + k0 + k32 + q * 8) = pack8(o);
        }
    }
    __syncthreads();
}

__device__ __forceinline__ void prep_transposes(const P& p, int it0, int it1, int rank, int nrank) {
    const int cnt[7] = {25 * 16, 16 * 16, 4 * 16, 4 * 32, 4 * 16, 22 * 16, 4 * 44};
    for (int it = it0 + rank; it < it1; it += nrank) {
        int m = 0, r = it;
#pragma unroll
        for (int i = 0; i < 6; ++i) if (m == i && r >= cnt[i]) { r -= cnt[i]; m = i + 1; }
        const float* src; int sstride, K, kT, mode = 0; size_t woff; const float* scale = nullptr;
        switch (m) {
            case 0: src = p.w_in; sstride = 10272; K = 1024; kT = 16; mode = 1; woff = W_WTA; break;
            case 1: src = p.w_in; sstride = 10272; K = 1024; kT = 16; mode = 2; woff = W_WTB; break;
            case 2: src = p.w_br_att; sstride = 1024; K = 1024; kT = 16; woff = W_WA; break;
            case 3: src = p.w_br_ssd; sstride = 1024; K = 2048; kT = 32; woff = W_WS; break;
            case 4: src = p.w_out; sstride = 1024; K = 1024; kT = 16; woff = W_WO; break;
            case 5: src = p.w_up; sstride = DFF2; K = 1024; kT = 16; woff = W_WUP; scale = p.g_ffn; break;
            default: src = p.w_down; sstride = 1024; K = DFF; kT = 44; woff = W_WDN; break;
        }
        const int nt = r / kT, kt = r - nt * kT;
        tr_tile(src, sstride, (bf16_t*)(p.ws + woff), K, nt * 256, kt * 64, mode, scale);
    }
}

__device__ __forceinline__ void phase_prep(const P& p) {
    prep_transposes(p, 0, 25 * 16, blockIdx.x, gridDim.x);
    const int wid = threadIdx.x >> 6, lane = threadIdx.x & 63;
    bf16_t* ub = (bf16_t*)(p.ws + W_UB);
    for (int row = blockIdx.x * 8 + wid; row < MR; row += gridDim.x * 8) {
        const float* hr = hrow(p, row);
        f32x4 v[4]; float ss = 0.f;
#pragma unroll
        for (int i = 0; i < 4; ++i) { v[i] = *(const f32x4*)(hr + i * 256 + lane * 4); ss += v[i][0] * v[i][0] + v[i][1] * v[i][1] + v[i][2] * v[i][2] + v[i][3] * v[i][3]; }
        ss = wave_sum(ss);
        const float rinv = rsqrtf(ss * (1.f / 1024.f) + EPS);
#pragma unroll
        for (int i = 0; i < 4; ++i) { f32x4 g = *(const f32x4*)(p.g_mix + i * 256 + lane * 4); st_bf4(ub + (size_t)row * 1024 + i * 256 + lane * 4, v[i] * rinv * g); }
    }
    float* r1 = (float*)(p.ws + W_RSQ1); float* r2 = (float*)(p.ws + W_RSQ2);
    for (int i = blockIdx.x * NTHR + threadIdx.x; i < MR; i += gridDim.x * NTHR) { r1[i] = 0.f; r2[i] = 0.f; }
}

template <bool SAMPLE, bool ISV>
__device__ __forceinline__ u32x4 kv_load8(const P& p, int seqrow0, int bs, int h, int key, int d0) {
    if (!SAMPLE) {
        const bf16_t* base = (const bf16_t*)(p.ws + (ISV ? W_VB : W_KB));
        return *(const u32x4*)(base + (size_t)(seqrow0 + key) * 1024 + h * 64 + d0);
    } else {
        if (key < PAST) {
            const float* src = (ISV ? p.cache_v : p.cache_k) + ((size_t)bs * PAST + key) * 1024 + h * 64 + d0;
            f32x4 a = *(const f32x4*)src, b = *(const f32x4*)(src + 4);
            u32x4 r; r.x = pk2(a[0], a[1]); r.y = pk2(a[2], a[3]); r.z = pk2(b[0], b[1]); r.w = pk2(b[2], b[3]); return r;
        } else if (key < PAST + LS) {
            const bf16_t* base = (const bf16_t*)(p.ws + (ISV ? W_VB : W_KB));
            return *(const u32x4*)(base + (size_t)(seqrow0 + (key - PAST)) * 1024 + h * 64 + d0);
        }
        return (u32x4){0u, 0u, 0u, 0u};
    }
}

template <bool SAMPLE, int NT>
__device__ __forceinline__ void attn_task(const P& p, int seqrow0  , int bs, int h, int q0  , int qrow0  , int ntile_valid, bf16_t* vt  ) {
    const int lane = threadIdx.x & 63, fr = lane & 15, fq = lane >> 4;
    bf16_t* qb = (bf16_t*)(p.ws + W_QB);
    bf16x8 qf0[NT], qf1[NT];
#pragma unroll
    for (int u = 0; u < NT; ++u) { const bf16_t* qp = qb + (size_t)(qrow0 + u * 16 + fr) * 1024 + h * 64 + fq * 8; qf0[u] = *(const bf16x8*)qp; qf1[u] = *(const bf16x8*)(qp + 32); }
    f32x4 o[NT][4];
    float Pc[NT];
#pragma unroll
    for (int u = 0; u < NT; ++u) { Pc[u] = 1.f;
#pragma unroll
        for (int i = 0; i < 4; ++i) o[u][i] = (f32x4){0.f, 0.f, 0.f, 0.f}; }
    const int kb0 = (q0 + 16 * (NT - 1) + 14) >> 6;
    u32x4 Kc[4][2], Vc[8];
#pragma unroll
    for (int kt = 0; kt < 4; ++kt) { const int key = kb0 * 64 + kt * 16 + fr; Kc[kt][0] = kv_load8<SAMPLE, false>(p, seqrow0, bs, h, key, fq * 8); Kc[kt][1] = kv_load8<SAMPLE, false>(p, seqrow0, bs, h, key, 32 + fq * 8); }
    const int vkr = lane & 7, vdc = lane >> 3;
#pragma unroll
    for (int i = 0; i < 8; ++i) Vc[i] = kv_load8<SAMPLE, true>(p, seqrow0, bs, h, kb0 * 64 + vkr * 8 + i, vdc * 8);
    for (int kb = kb0; kb >= 0; --kb) {
        f32x4 zt[NT][4];
#pragma unroll
        for (int kt = 0; kt < 4; ++kt)
#pragma unroll
            for (int u = 0; u < NT; ++u) {
                f32x4 a = (f32x4){0.f, 0.f, 0.f, 0.f};
                a = __builtin_amdgcn_mfma_f32_16x16x32_bf16(__builtin_bit_cast(bf16x8, Kc[kt][0]), qf0[u], a, 0, 0, 0);
                a = __builtin_amdgcn_mfma_f32_16x16x32_bf16(__builtin_bit_cast(bf16x8, Kc[kt][1]), qf1[u], a, 0, 0, 0);
                zt[u][kt] = a;
            }
#pragma unroll
        for (int jp = 0; jp < 4; ++jp) {
            u32x4 lo, hi;
            lo.x = (Vc[0][jp] & 0xffffu) | (Vc[1][jp] << 16); lo.y = (Vc[2][jp] & 0xffffu) | (Vc[3][jp] << 16); lo.z = (Vc[4][jp] & 0xffffu) | (Vc[5][jp] << 16); lo.w = (Vc[6][jp] & 0xffffu) | (Vc[7][jp] << 16);
            hi.x = (Vc[0][jp] >> 16) | (Vc[1][jp] & 0xffff0000u); hi.y = (Vc[2][jp] >> 16) | (Vc[3][jp] & 0xffff0000u); hi.z = (Vc[4][jp] >> 16) | (Vc[5][jp] & 0xffff0000u); hi.w = (Vc[6][jp] >> 16) | (Vc[7][jp] & 0xffff0000u);
            *(u32x4*)(vt + (vdc * 8 + 2 * jp) * 72 + vkr * 8) = lo;
            *(u32x4*)(vt + (vdc * 8 + 2 * jp + 1) * 72 + vkr * 8) = hi;
        }
        if (kb > 0) {
#pragma unroll
            for (int kt = 0; kt < 4; ++kt) { const int key = (kb - 1) * 64 + kt * 16 + fr; Kc[kt][0] = kv_load8<SAMPLE, false>(p, seqrow0, bs, h, key, fq * 8); Kc[kt][1] = kv_load8<SAMPLE, false>(p, seqrow0, bs, h, key, 32 + fq * 8); }
#pragma unroll
            for (int i = 0; i < 8; ++i) Vc[i] = kv_load8<SAMPLE, true>(p, seqrow0, bs, h, (kb - 1) * 64 + vkr * 8 + i, vdc * 8);
        }
        u32x4 wf[NT][2];
#pragma unroll
        for (int u = 0; u < NT; ++u) {
            const int qpos = q0 + u * 16 + fr;
            float kp[4][4], run[4], above[4], tot[4];
#pragma unroll
            for (int kt = 0; kt < 4; ++kt) {
                run[kt] = 1.f;
#pragma unroll
                for (int r = 0; r < 4; ++r) {
                    const int key = kb * 64 + kt * 16 + fq * 4 + r;
                    const bool v = key < qpos;
                    const float e = __expf(fminf(zt[u][kt][r], 80.f)); const float rt = __builtin_amdgcn_rcpf(1.f + e);
                    kp[kt][r] = v ? rt : 1.f; run[kt] *= kp[kt][r];
                }
                const float a1 = __shfl_down(run[kt], 16), a2 = __shfl_down(run[kt], 32), a3 = __shfl_down(run[kt], 48);
                above[kt] = (fq < 3 ? a1 : 1.f) * (fq < 2 ? a2 : 1.f) * (fq < 1 ? a3 : 1.f);
                tot[kt] = __shfl(run[kt] * above[kt], fr);
            }
            float later = Pc[u]; float w[4][4];
#pragma unroll
            for (int kt = 3; kt >= 0; --kt) {
                const float base = above[kt] * later; float s3 = 1.f;
#pragma unroll
                for (int r = 3; r >= 0; --r) { w[kt][r] = (1.f - kp[kt][r]) * (s3 * base); s3 *= kp[kt][r]; }
                later *= tot[kt];
            }
            Pc[u] = later;
#pragma unroll
            for (int ks = 0; ks < 2; ++ks) { wf[u][ks].x = pk2(w[2 * ks][0], w[2 * ks][1]); wf[u][ks].y = pk2(w[2 * ks][2], w[2 * ks][3]); wf[u][ks].z = pk2(w[2 * ks + 1][0], w[2 * ks + 1][1]); wf[u][ks].w = pk2(w[2 * ks + 1][2], w[2 * ks + 1][3]); }
        }
        asm volatile("s_waitcnt lgkmcnt(0)" ::: "memory");
        __builtin_amdgcn_wave_barrier();
#pragma unroll
        for (int ks = 0; ks < 2; ++ks) {
#pragma unroll
            for (int dt = 0; dt < 4; ++dt) {
                const bf16_t* vp = vt + (dt * 16 + fr) * 72 + ks * 32 + fq * 4;
                u32x2 lo = *(const u32x2*)vp, hi = *(const u32x2*)(vp + 16);
                u32x4 vf; vf.x = lo.x; vf.y = lo.y; vf.z = hi.x; vf.w = hi.y;
#pragma unroll
                for (int u = 0; u < NT; ++u) o[u][dt] = __builtin_amdgcn_mfma_f32_16x16x32_bf16(__builtin_bit_cast(bf16x8, vf), __builtin_bit_cast(bf16x8, wf[u][ks]), o[u][dt], 0, 0, 0);
            }
        }
        asm volatile("s_waitcnt lgkmcnt(0)" ::: "memory");
        __builtin_amdgcn_wave_barrier();
        bool done = Pc[0] < 1e-37f;
#pragma unroll
        for (int u = 1; u < NT; ++u) done = done && (Pc[u] < 1e-37f);
        if (__all(done)) break;
    }
    bf16_t* attb = (bf16_t*)(p.ws + W_ATT);
#pragma unroll
    for (int u = 0; u < NT; ++u) if (u < ntile_valid) {
#pragma unroll
        for (int dt = 0; dt < 4; ++dt) st_bf4(attb + (size_t)(qrow0 + u * 16 + fr) * 1024 + h * 64 + dt * 16 + fq * 4, o[u][dt]);
    }
}

constexpr int ATT_TASKS_PAIR = NBP * 16 * 128, ATT_TASKS_P = ATT_TASKS_PAIR + NBP * 16, ATT_TASKS = ATT_TASKS_P + NBS * 16;
__device__ __forceinline__ void attn_wave(const P& p, int task) {
    const int wid = threadIdx.x >> 6;
    bf16_t* vt = (bf16_t*)smem + wid * (64 * 72);
    if (task < ATT_TASKS_PAIR) {
        const int pr = task & 127, bh = task >> 7, h = bh & 15, b = bh >> 4;
        attn_task<false, 2>(p, b * LP, b, h, pr * 32, b * LP + pr * 32, 2, vt);
    } else if (task < ATT_TASKS_P) {
        const int bh = task - ATT_TASKS_PAIR, h = bh & 15, b = bh >> 4;
        attn_task<false, 1>(p, b * LP, b, h, 4096, b * LP + 4096, 1, vt);
    } else if (task < ATT_TASKS) {
        const int s = task - ATT_TASKS_P, b = s >> 4, h = s & 15;
        attn_task<true, 1>(p, NP + b * LS, b, h, PAST, NP + b * LS, 1, vt);
    }
}

struct ChunkInfo { int rowbase, L, pad, c, sb; };
__device__ __forceinline__ ChunkInfo chunk_info(int gc) {
    ChunkInfo ci;
    if (gc < NBP * NCH_P) { ci.sb = gc / NCH_P; ci.c = gc - ci.sb * NCH_P; ci.rowbase = ci.sb * LP; ci.L = LP; ci.pad = 48; }
    else { ci.sb = 4 + (gc - NBP * NCH_P); ci.c = 0; ci.rowbase = NP + (gc - NBP * NCH_P) * LS; ci.L = LS; ci.pad = 0; }
    return ci;
}
__device__ __forceinline__ void conv_ssd8(const P& p, const ChunkInfo& ci, int t, int ch0, float (&o)[8]) {
    const bf16_t* xpre = (const bf16_t*)(p.ws + W_XPRE);
    float acc[8];
    { f32x4 b0 = *(const f32x4*)(p.conv_b_ssd + ch0), b1 = *(const f32x4*)(p.conv_b_ssd + ch0 + 4);
      acc[0] = b0[0]; acc[1] = b0[1]; acc[2] = b0[2]; acc[3] = b0[3]; acc[4] = b1[0]; acc[5] = b1[1]; acc[6] = b1[2]; acc[7] = b1[3]; }
#pragma unroll
    for (int i = 0; i < 4; ++i) {
        const int tt = t - 3 + i;
        float x[8];
        if (tt >= 0) { u32x4 v = *(const u32x4*)(xpre + (size_t)(ci.rowbase + tt) * XBC + ch0); unpack8(v, x); }
        else if (ci.sb >= 4) { const float* s = p.state_ssm_conv + ((size_t)(ci.sb - 4) * 3 + (3 + tt)) * XBC + ch0; f32x4 a = *(const f32x4*)s, b = *(const f32x4*)(s + 4);
            x[0] = a[0]; x[1] = a[1]; x[2] = a[2]; x[3] = a[3]; x[4] = b[0]; x[5] = b[1]; x[6] = b[2]; x[7] = b[3]; }
        else {
#pragma unroll
            for (int j = 0; j < 8; ++j) x[j] = 0.f; }
        const float* wp = p.conv_w_ssd + (size_t)i * XBC + ch0; f32x4 w0 = *(const f32x4*)wp, w1 = *(const f32x4*)(wp + 4);
        acc[0] += w0[0] * x[0]; acc[1] += w0[1] * x[1]; acc[2] += w0[2] * x[2]; acc[3] += w0[3] * x[3];
        acc[4] += w1[0] * x[4]; acc[5] += w1[1] * x[5]; acc[6] += w1[2] * x[6]; acc[7] += w1[3] * x[7];
    }
#pragma unroll
    for (int j = 0; j < 8; ++j) o[j] = silu_f(acc[j]);
}
struct XPre { u32x4 r[4]; f32x4 w[4][2]; f32x4 b[2]; };
__device__ __forceinline__ void xpre_load(const P& p, const ChunkInfo& ci, int t, bool valid, int ch0, XPre& x) {
    const bf16_t* xpre = (const bf16_t*)(p.ws + W_XPRE);
#pragma unroll
    for (int i = 0; i < 4; ++i) {
        const int tt = t - 3 + i;
        x.r[i] = (u32x4){0u, 0u, 0u, 0u};
        if (valid) {
            if (tt >= 0) x.r[i] = *(const u32x4*)(xpre + (size_t)(ci.rowbase + tt) * XBC + ch0);
            else if (ci.sb >= 4) { const float* s = p.state_ssm_conv + ((size_t)(ci.sb - 4) * 3 + (3 + tt)) * XBC + ch0; f32x4 a = *(const f32x4*)s, b = *(const f32x4*)(s + 4);
                x.r[i].x = pk2(a[0], a[1]); x.r[i].y = pk2(a[2], a[3]); x.r[i].z = pk2(b[0], b[1]); x.r[i].w = pk2(b[2], b[3]); }
        }
        const float* wp = p.conv_w_ssd + (size_t)i * XBC + ch0; x.w[i][0] = *(const f32x4*)wp; x.w[i][1] = *(const f32x4*)(wp + 4);
    }
    x.b[0] = *(const f32x4*)(p.conv_b_ssd + ch0); x.b[1] = *(const f32x4*)(p.conv_b_ssd + ch0 + 4);
}
__device__ __forceinline__ void xpre_compute(const XPre& x, bool valid, float (&o)[8]) {
    float acc[8] = {x.b[0][0], x.b[0][1], x.b[0][2], x.b[0][3], x.b[1][0], x.b[1][1], x.b[1][2], x.b[1][3]};
#pragma unroll
    for (int i = 0; i < 4; ++i) {
        float v[8]; unpack8(x.r[i], v);
        acc[0] += x.w[i][0][0] * v[0]; acc[1] += x.w[i][0][1] * v[1]; acc[2] += x.w[i][0][2] * v[2]; acc[3] += x.w[i][0][3] * v[3];
        acc[4] += x.w[i][1][0] * v[4]; acc[5] += x.w[i][1][1] * v[5]; acc[6] += x.w[i][1][2] * v[6]; acc[7] += x.w[i][1][3] * v[7];
    }
#pragma unroll
    for (int j = 0; j < 8; ++j) o[j] = valid ? silu_f(acc[j]) : 0.f;
}
__device__ __forceinline__ void chunk_dt(const P& p, const ChunkInfo& ci, int h, int lane, float& dtv, float& acum, float& alast) {
    const float* dtr = (const float*)(p.ws + W_DT);
    const int t = ci.c * 64 + lane - ci.pad; const bool valid = t >= 0 && t < ci.L;
    dtv = 0.f;
    if (valid) { const float x = dtr[(size_t)(ci.rowbase + t) * 32 + h] + p.dt_bias[h]; const float e = __expf(-fabsf(x));
        dtv = fmaxf(x, 0.f) + (e < 0.01f ? e * (1.f - e * (0.5f - e * 0.33333334f)) : __logf(1.f + e)); }
    const float a = -__expf(p.a_log[h]);
    float x = dtv * a;
#pragma unroll
    for (int off = 1; off < 64; off <<= 1) { const float y = __shfl_up(x, off); if (lane >= off) x += y; }
    acum = x; alast = __shfl(x, 63);
}

__device__ __forceinline__ void wave_xtile(const P& p, const ChunkInfo& ci, int h, int lane, bf16_t* xtw, const float* te) {
    const bf16_t* xpre = (const bf16_t*)(p.ws + W_XPRE);
    const int chunk = lane & 7, s0 = (lane >> 3) * 8, ch0 = h * 64 + chunk * 8;
    const int tok0 = ci.c * 64 + s0 - ci.pad;
    u32x4 rows[11];
#pragma unroll
    for (int i = 0; i < 11; ++i) {
        const int tt = tok0 - 3 + i;
        rows[i] = (u32x4){0u, 0u, 0u, 0u};
        if (tt >= 0 && tt < ci.L) rows[i] = *(const u32x4*)(xpre + (size_t)(ci.rowbase + tt) * XBC + ch0);
        else if (tt < 0 && tt >= -3 && ci.sb >= 4) { const float* sp_ = p.state_ssm_conv + ((size_t)(ci.sb - 4) * 3 + (3 + tt)) * XBC + ch0; f32x4 a = *(const f32x4*)sp_, b = *(const f32x4*)(sp_ + 4);
            rows[i].x = pk2(a[0], a[1]); rows[i].y = pk2(a[2], a[3]); rows[i].z = pk2(b[0], b[1]); rows[i].w = pk2(b[2], b[3]); }
    }
    float w[4][8], bias[8];
#pragma unroll
    for (int i = 0; i < 4; ++i) { const float* wp = p.conv_w_ssd + (size_t)i * XBC + ch0; f32x4 a = *(const f32x4*)wp, b = *(const f32x4*)(wp + 4);
        w[i][0] = a[0]; w[i][1] = a[1]; w[i][2] = a[2]; w[i][3] = a[3]; w[i][4] = b[0]; w[i][5] = b[1]; w[i][6] = b[2]; w[i][7] = b[3]; }
    { f32x4 a = *(const f32x4*)(p.conv_b_ssd + ch0), b = *(const f32x4*)(p.conv_b_ssd + ch0 + 4);
      bias[0] = a[0]; bias[1] = a[1]; bias[2] = a[2]; bias[3] = a[3]; bias[4] = b[0]; bias[5] = b[1]; bias[6] = b[2]; bias[7] = b[3]; }
    unsigned pk[8][4];
#pragma unroll
    for (int tp = 0; tp < 4; ++tp) {
        float o[2][8];
#pragma unroll
        for (int e = 0; e < 2; ++e) {
            const int ti = tp * 2 + e;
            const int tok = tok0 + ti; const bool valid = tok >= 0 && tok < ci.L;
            float acc[8];
#pragma unroll
            for (int j = 0; j < 8; ++j) acc[j] = bias[j];
#pragma unroll
            for (int i = 0; i < 4; ++i) { float v[8]; unpack8(rows[ti + i], v);
#pragma unroll
                for (int j = 0; j < 8; ++j) acc[j] += w[i][j] * v[j]; }
            const float sc = te ? te[s0 + ti] : 1.f;
#pragma unroll
            for (int j = 0; j < 8; ++j) o[e][j] = valid ? silu_f(acc[j]) * sc : 0.f;
        }
#pragma unroll
        for (int j = 0; j < 8; ++j) pk[j][tp] = pk2(o[0][j], o[1][j]);
    }
#pragma unroll
    for (int j = 0; j < 8; ++j) { u32x4 v; v.x = pk[j][0]; v.y = pk[j][1]; v.z = pk[j][2]; v.w = pk[j][3]; *(u32x4*)(xtw + (chunk * 8 + j) * 72 + s0) = v; }
    asm volatile("s_waitcnt lgkmcnt(0)" ::: "memory");
    __builtin_amdgcn_wave_barrier();
}

__device__ __forceinline__ void ssd1_unit(const P& p, int unit) {
    const int gc = unit >> 2, g = unit & 3;
    const ChunkInfo ci = chunk_info(gc);
    const int tid = threadIdx.x, wid = tid >> 6, lane = tid & 63, fr = lane & 15, fq = lane >> 4;
    float* toend = (float*)smem;
    bf16_t* BT = (bf16_t*)(smem + 2048);
    bf16_t* XT = (bf16_t*)(smem + 2048 + 128 * 72 * 2);
    bf16_t* cs = (bf16_t*)(p.ws + W_CS); float* dec = (float*)(p.ws + W_DEC);
    {
        float dtv, acum, alast; chunk_dt(p, ci, g * 8 + wid, lane, dtv, acum, alast);
        toend[wid * 64 + lane] = __expf(alast - acum) * dtv;
        if (lane == 0) dec[gc * 32 + g * 8 + wid] = __expf(alast);
    }
#pragma unroll
    for (int i = 0; i < 2; ++i) {
        const int item = tid + 512 * i, s = item >> 4, chunk = item & 15;
        const int t = ci.c * 64 + s - ci.pad; float o[8];
        if (t >= 0 && t < ci.L) conv_ssd8(p, ci, t, SSDW + g * 128 + chunk * 8, o);
        else {
#pragma unroll
            for (int j = 0; j < 8; ++j) o[j] = 0.f; }
#pragma unroll
        for (int j = 0; j < 8; ++j) BT[(chunk * 8 + j) * 72 + s] = f2bf(o[j]);
    }
    __syncthreads();
    {
        const int h = g * 8 + wid;
        bf16_t* xt = XT + wid * (64 * 72);
        wave_xtile(p, ci, h, lane, xt, toend + wid * 64);
        bf16x8 xf[4][2];
#pragma unroll
        for (int pt = 0; pt < 4; ++pt)
#pragma unroll
            for (int ks = 0; ks < 2; ++ks) xf[pt][ks] = *(const bf16x8*)(xt + (pt * 16 + fr) * 72 + ks * 32 + fq * 8);
#pragma unroll
        for (int nt = 0; nt < 8; ++nt) {
            bf16x8 bfr[2];
#pragma unroll
            for (int ks = 0; ks < 2; ++ks) bfr[ks] = *(const bf16x8*)(BT + (nt * 16 + fr) * 72 + ks * 32 + fq * 8);
#pragma unroll
            for (int pt = 0; pt < 4; ++pt) {
                f32x4 a = (f32x4){0.f, 0.f, 0.f, 0.f};
#pragma unroll
                for (int ks = 0; ks < 2; ++ks) a = __builtin_amdgcn_mfma_f32_16x16x32_bf16(bfr[ks], xf[pt][ks], a, 0, 0, 0);
                st_bf4(cs + (((size_t)gc * 32 + h) * 64 + pt * 16 + fr) * 128 + nt * 16 + fq * 4, a);
            }
        }
    }
    __syncthreads();
}

__device__ __forceinline__ void phase_scan(const P& p) {
    bf16_t* cs = (bf16_t*)(p.ws + W_CS); const float* dec = (const float*)(p.ws + W_DEC);
    const int gsz = gridDim.x * NTHR;
    for (int T = blockIdx.x * NTHR + threadIdx.x; T < NBP * 32 * 1024; T += gsz) {
        const int b = T >> 15, rem = T & 32767, h = rem >> 10, pn8 = rem & 1023;
        float st[8];
#pragma unroll
        for (int j = 0; j < 8; ++j) st[j] = 0.f;
        for (int c0 = 0; c0 < NCH_P; c0 += 13) {
            u32x4 v[13]; float d[13];
#pragma unroll
            for (int i = 0; i < 13; ++i) { const int gc = b * NCH_P + c0 + i; v[i] = *(const u32x4*)(cs + ((size_t)gc * 32 + h) * 8192 + pn8 * 8); d[i] = dec[gc * 32 + h]; }
#pragma unroll
            for (int i = 0; i < 13; ++i) {
                const int gc = b * NCH_P + c0 + i; float x[8]; unpack8(v[i], x);
                *(u32x4*)(cs + ((size_t)gc * 32 + h) * 8192 + pn8 * 8) = pack8(st);
#pragma unroll
                for (int j = 0; j < 8; ++j) st[j] = d[i] * st[j] + x[j];
            }
        }
        float* o = p.out + O_SSMP + ((size_t)b * 32 + h) * 8192 + pn8 * 8;
#ifdef SANITIZE
#pragma unroll
        for (int j = 0; j < 8; ++j) if (!(fabsf(st[j]) < 1e30f)) st[j] = 777.f;
#endif
        *(f32x4*)o = (f32x4){st[0], st[1], st[2], st[3]}; *(f32x4*)(o + 4) = (f32x4){st[4], st[5], st[6], st[7]};
    }
    for (int T0 = blockIdx.x * NTHR + threadIdx.x; T0 < NBS * 32 * 1024; T0 += gsz * 4) {
        f32x4 sa[4], sc[4]; u32x4 xv[4]; float dd[4];
#pragma unroll
        for (int i = 0; i < 4; ++i) { const int T = T0 + i * gsz; if (T < NBS * 32 * 1024) {
            const int b = T >> 15, rem = T & 32767, h = rem >> 10, pn8 = rem & 1023; const int gc = NBP * NCH_P + b;
            const float* s0 = p.state_ssm + ((size_t)b * 32 + h) * 8192 + pn8 * 8;
            sa[i] = *(const f32x4*)s0; sc[i] = *(const f32x4*)(s0 + 4);
            xv[i] = *(const u32x4*)(cs + ((size_t)gc * 32 + h) * 8192 + pn8 * 8); dd[i] = dec[gc * 32 + h]; } }
#pragma unroll
        for (int i = 0; i < 4; ++i) { const int T = T0 + i * gsz; if (T < NBS * 32 * 1024) {
            const int b = T >> 15, rem = T & 32767, h = rem >> 10, pn8 = rem & 1023; const int gc = NBP * NCH_P + b;
            float st[8] = {sa[i][0], sa[i][1], sa[i][2], sa[i][3], sc[i][0], sc[i][1], sc[i][2], sc[i][3]};
            float x[8]; unpack8(xv[i], x);
            *(u32x4*)(cs + ((size_t)gc * 32 + h) * 8192 + pn8 * 8) = pack8(st);
            const float d = dd[i];
            float* o = p.out + O_SSMS + ((size_t)b * 32 + h) * 8192 + pn8 * 8;
            *(f32x4*)o = (f32x4){d * st[0] + x[0], d * st[1] + x[1], d * st[2] + x[2], d * st[3] + x[3]};
            *(f32x4*)(o + 4) = (f32x4){d * st[4] + x[4], d * st[5] + x[5], d * st[6] + x[6], d * st[7] + x[7]}; } }
    }
}

__device__ __forceinline__ void ssd3_unit(const P& p, int unit) {
    const int gc = unit >> 2, g = unit & 3;
    const ChunkInfo ci = chunk_info(gc);
    const int tid = threadIdx.x, wid = tid >> 6, lane = tid & 63, fr = lane & 15, fq = lane >> 4;
    float* acl = (float*)smem;
    float* dtl = (float*)(smem + 2048);
    bf16_t* Cs = (bf16_t*)(smem + 4096);
    bf16_t* Bs = (bf16_t*)(smem + 21504);
    float* CB = (float*)(smem + 38912);
    bf16_t* XT = (bf16_t*)(smem + 56320);
    const bf16_t* hin = (const bf16_t*)(p.ws + W_CS); bf16_t* yssd = (bf16_t*)(p.ws + W_YSSD);
    {
        float dtv, acum, alast; chunk_dt(p, ci, g * 8 + wid, lane, dtv, acum, alast);
        acl[wid * 64 + lane] = acum; dtl[wid * 64 + lane] = dtv;
    }
#pragma unroll
    for (int i = 0; i < 4; ++i) {
        const int item = tid + 512 * i, isC = item >> 10, it2 = item & 1023, s = it2 >> 4, chunk = it2 & 15;
        const int t = ci.c * 64 + s - ci.pad; float o[8];
        if (t >= 0 && t < ci.L) conv_ssd8(p, ci, t, SSDW + isC * 512 + g * 128 + chunk * 8, o);
        else {
#pragma unroll
            for (int j = 0; j < 8; ++j) o[j] = 0.f; }
        *(u32x4*)((isC ? Cs : Bs) + s * 136 + chunk * 8) = pack8(o);
    }
    __syncthreads();
    {
        const int tt = wid >> 1;
#pragma unroll
        for (int si = 0; si < 2; ++si) {
            const int st = (wid & 1) * 2 + si;
            f32x4 a = (f32x4){0.f, 0.f, 0.f, 0.f};
#pragma unroll
            for (int ks = 0; ks < 4; ++ks) {
                bf16x8 cf = *(const bf16x8*)(Cs + (tt * 16 + fr) * 136 + ks * 32 + fq * 8), bfg = *(const bf16x8*)(Bs + (st * 16 + fr) * 136 + ks * 32 + fq * 8);
                a = __builtin_amdgcn_mfma_f32_16x16x32_bf16(cf, bfg, a, 0, 0, 0);
            }
#pragma unroll
            for (int r = 0; r < 4; ++r) CB[(tt * 16 + fq * 4 + r) * 68 + st * 16 + fr] = a[r];
        }
    }
    __syncthreads();
    {
        const int h = g * 8 + wid;
        bf16_t* xt = XT + wid * (64 * 72);
        wave_xtile(p, ci, h, lane, xt, nullptr);
        bf16x8 hf[4][4];
#pragma unroll
        for (int pt = 0; pt < 4; ++pt) { const bf16_t* hp = hin + (((size_t)gc * 32 + h) * 64 + pt * 16 + fr) * 128 + fq * 8;
#pragma unroll
            for (int ks = 0; ks < 4; ++ks) hf[pt][ks] = *(const bf16x8*)(hp + ks * 32); }
        const float dsk = p.d_skip[h];
        const float* aw = acl + wid * 64; const float* dw = dtl + wid * 64;
#pragma unroll 1
        for (int tt = 0; tt < 4; ++tt) {
            const int tq = tt * 16 + fr;
            const int tok = ci.c * 64 + tq - ci.pad; const bool valid = tok >= 0 && tok < ci.L;
            const float at = aw[tq]; const float ea = __expf(at);
            bf16x8 mf[2], cf[4];
#pragma unroll
            for (int ks = 0; ks < 2; ++ks) {
                const int sb0 = ks * 32 + fq * 8;
                f32x4 c0 = *(const f32x4*)(CB + tq * 68 + sb0), c1 = *(const f32x4*)(CB + tq * 68 + sb0 + 4);
                f32x4 a0 = *(const f32x4*)(aw + sb0), a1 = *(const f32x4*)(aw + sb0 + 4), d0 = *(const f32x4*)(dw + sb0), d1 = *(const f32x4*)(dw + sb0 + 4);
                float mv[8];
#pragma unroll
                for (int j = 0; j < 4; ++j) { mv[j] = (sb0 + j) <= tq ? c0[j] * __expf(at - a0[j]) * d0[j] : 0.f; mv[4 + j] = (sb0 + 4 + j) <= tq ? c1[j] * __expf(at - a1[j]) * d1[j] : 0.f; }
                mf[ks] = __builtin_bit_cast(bf16x8, pack8(mv));
            }
#pragma unroll
            for (int ks = 0; ks < 4; ++ks) cf[ks] = *(const bf16x8*)(Cs + tq * 136 + ks * 32 + fq * 8);
#pragma unroll
            for (int pt = 0; pt < 4; ++pt) {
                f32x4 a1 = (f32x4){0.f, 0.f, 0.f, 0.f}, a2 = (f32x4){0.f, 0.f, 0.f, 0.f};
#pragma unroll
                for (int ks = 0; ks < 2; ++ks) { bf16x8 xf = *(const bf16x8*)(xt + (pt * 16 + fr) * 72 + ks * 32 + fq * 8); a1 = __builtin_amdgcn_mfma_f32_16x16x32_bf16(xf, mf[ks], a1, 0, 0, 0); }
#pragma unroll
                for (int ks = 0; ks < 4; ++ks) a2 = __builtin_amdgcn_mfma_f32_16x16x32_bf16(hf[pt][ks], cf[ks], a2, 0, 0, 0);
                f32x4 y;
#pragma unroll
                for (int r = 0; r < 4; ++r) y[r] = a1[r] + ea * a2[r] + dsk * bf2f(xt[(pt * 16 + fq * 4 + r) * 72 + tq]);
                if (valid) st_bf4(yssd + (size_t)(ci.rowbase + tok) * 2048 + h * 64 + pt * 16 + fq * 4, y);
            }
        }
    }
    __syncthreads();
}

__device__ __forceinline__ void phase_gate(const P& p) {
    bf16_t* yssd = (bf16_t*)(p.ws + W_YSSD); const bf16_t* zb = (const bf16_t*)(p.ws + W_ZB);
    const int wid = threadIdx.x >> 6, lane = threadIdx.x & 63;
    for (int task = blockIdx.x * 8 + wid; task < MR * 4; task += gridDim.x * 8) {
        const int row = task >> 2, g = task & 3;
        const size_t off = (size_t)row * 2048 + g * 512 + lane * 8;
        float y[8], z[8]; unpack8(*(const u32x4*)(yssd + off), y); unpack8(*(const u32x4*)(zb + off), z);
        float ss = 0.f;
#pragma unroll
        for (int j = 0; j < 8; ++j) { y[j] *= silu_f(z[j]); ss += y[j] * y[j]; }
        ss = wave_sum(ss);
        const float rinv = rsqrtf(ss * (1.f / 512.f) + EPS);
        const float* gp = p.g_ssd_norm + g * 512 + lane * 8; f32x4 g0 = *(const f32x4*)gp, g1 = *(const f32x4*)(gp + 4);
        y[0] *= rinv * g0[0]; y[1] *= rinv * g0[1]; y[2] *= rinv * g0[2]; y[3] *= rinv * g0[3];
        y[4] *= rinv * g1[0]; y[5] *= rinv * g1[1]; y[6] *= rinv * g1[2]; y[7] *= rinv * g1[3];
        *(u32x4*)(yssd + off) = pack8(y);
    }
}

constexpr int ACT_SEG = 47, ACT_NSEG = (MR + ACT_SEG - 1) / ACT_SEG, ACT_CG = DFF / 8;
struct ActRow { u32x4 g, v; };
__device__ __forceinline__ ActRow act_loadrow(const P& p, int row_t  , int rb, int sbs, int j0) {
    const bf16_t* upb = (const bf16_t*)(p.ws + W_UPB);
    ActRow r; r.g = (u32x4){0u, 0u, 0u, 0u}; r.v = r.g;
    if (row_t >= 0) { const bf16_t* q = upb + (size_t)(rb + row_t) * DFF2 + j0; r.g = *(const u32x4*)q; r.v = *(const u32x4*)(q + DFF); }
    else if (sbs >= 0) { const float* s = p.state_ffn_conv + ((size_t)sbs * 2 + (2 + row_t)) * DFF2 + j0;
        f32x4 a = *(const f32x4*)s, b = *(const f32x4*)(s + 4), c = *(const f32x4*)(s + DFF), d = *(const f32x4*)(s + DFF + 4);
        r.g.x = pk2(a[0], a[1]); r.g.y = pk2(a[2], a[3]); r.g.z = pk2(b[0], b[1]); r.g.w = pk2(b[2], b[3]);
        r.v.x = pk2(c[0], c[1]); r.v.y = pk2(c[2], c[3]); r.v.z = pk2(d[0], d[1]); r.v.w = pk2(d[2], d[3]); }
    return r;
}
__device__ __forceinline__ void phase_act(const P& p) {
    bf16_t* act = (bf16_t*)(p.ws + W_ACT);
    for (int T = blockIdx.x * NTHR + threadIdx.x; T < ACT_CG * ACT_NSEG; T += gridDim.x * NTHR) {
        const int seg = T / ACT_CG, j0 = (T - seg * ACT_CG) * 8;
        const int r0 = seg * ACT_SEG, r1 = (r0 + ACT_SEG) < MR ? (r0 + ACT_SEG) : MR;
        float wg[3][8], wv[3][8], bg[8], bv[8];
#pragma unroll
        for (int i = 0; i < 3; ++i) {
            const float* wp = p.conv_w_ffn + (size_t)i * DFF2 + j0; f32x4 a = *(const f32x4*)wp, b = *(const f32x4*)(wp + 4), c = *(const f32x4*)(wp + DFF), d = *(const f32x4*)(wp + DFF + 4);
            wg[i][0] = a[0]; wg[i][1] = a[1]; wg[i][2] = a[2]; wg[i][3] = a[3]; wg[i][4] = b[0]; wg[i][5] = b[1]; wg[i][6] = b[2]; wg[i][7] = b[3];
            wv[i][0] = c[0]; wv[i][1] = c[1]; wv[i][2] = c[2]; wv[i][3] = c[3]; wv[i][4] = d[0]; wv[i][5] = d[1]; wv[i][6] = d[2]; wv[i][7] = d[3];
        }
        { const float* bp = p.conv_b_ffn + j0; f32x4 a = *(const f32x4*)bp, b = *(const f32x4*)(bp + 4), c = *(const f32x4*)(bp + DFF), d = *(const f32x4*)(bp + DFF + 4);
          bg[0] = a[0]; bg[1] = a[1]; bg[2] = a[2]; bg[3] = a[3]; bg[4] = b[0]; bg[5] = b[1]; bg[6] = b[2]; bg[7] = b[3];
          bv[0] = c[0]; bv[1] = c[1]; bv[2] = c[2]; bv[3] = c[3]; bv[4] = d[0]; bv[5] = d[1]; bv[6] = d[2]; bv[7] = d[3]; }
        ActRow m2, m1, cur, d0, d1, d2;
        int t, sbs, rb;
#define ACT_DECODE(row_) do { if ((row_) < NP) { const int b_ = (row_) / LP; t = (row_) - b_ * LP; rb = b_ * LP; sbs = -1; } else { const int r2_ = (row_) - NP; sbs = r2_ >> 4; t = r2_ & 15; rb = NP + sbs * LS; } } while (0)
#define ACT_LOADROW(dst, row_) do { int t_; int rb_; if ((row_) < NP) { const int b_ = (row_) / LP; t_ = (row_) - b_ * LP; rb_ = b_ * LP; } else { const int r2_ = (row_) - NP; t_ = r2_ & 15; rb_ = NP + (r2_ >> 4) * LS; } dst = act_loadrow(p, t_, rb_, -1, j0); } while (0)
        ACT_DECODE(r0);
        m2 = act_loadrow(p, t - 2, rb, sbs, j0); m1 = act_loadrow(p, t - 1, rb, sbs, j0);
        ACT_LOADROW(d0, r0); d1 = d0; d2 = d0;
        if (r0 + 1 < r1) ACT_LOADROW(d1, r0 + 1);
        if (r0 + 2 < r1) ACT_LOADROW(d2, r0 + 2);
        for (int row = r0; row < r1; ++row) {
            cur = d0; d0 = d1; d1 = d2;
            if (row + 3 < r1) ACT_LOADROW(d2, row + 3);
            ACT_DECODE(row);
            if (t == 0) { m2 = act_loadrow(p, -2, rb, sbs, j0); m1 = act_loadrow(p, -1, rb, sbs, j0); }
            else if (t == 1) { m2 = act_loadrow(p, -1, rb, sbs, j0); }
            const ActRow n2 = m1, n1 = cur;
            float x0[8], x1[8], x2[8], y0[8], y1[8], y2[8], o[8];
            unpack8(m2.g, x0); unpack8(m1.g, x1); unpack8(cur.g, x2); unpack8(m2.v, y0); unpack8(m1.v, y1); unpack8(cur.v, y2);
#pragma unroll
            for (int j = 0; j < 8; ++j) {
                const float gg = bg[j] + wg[0][j] * x0[j] + wg[1][j] * x1[j] + wg[2][j] * x2[j];
                const float vv = bv[j] + wv[0][j] * y0[j] + wv[1][j] * y1[j] + wv[2][j] * y2[j];
                o[j] = silu_f(gg) * vv;
            }
            *(u32x4*)(act + (size_t)row * DFF + j0) = pack8(o);
            m2 = n2; m1 = n1;
        }
    }
}

__device__ __forceinline__ void phase_final(const P& p) {
    const bf16_t* h2 = (const bf16_t*)(p.ws + W_H1B); const float* rsq = (const float*)(p.ws + W_RSQ2);
    const int wid = threadIdx.x >> 6, lane = threadIdx.x & 63;
    for (int row = blockIdx.x * 8 + wid; row < MR; row += gridDim.x * 8) {
        float* o;
        if (row < NP) { const int b = row / LP, t = row - b * LP; if (t < 16) continue; o = p.out + O_YP + ((size_t)b * SEQ + (t - 16)) * DM; }
        else o = p.out + O_YS + (size_t)(row - NP) * DM;
        const float rinv = rsqrtf(__builtin_nontemporal_load(rsq + row) * (1.f / 1024.f) + EPS);
#pragma unroll
        for (int i = 0; i < 2; ++i) {
            const int c = i * 512 + lane * 8;
            float v[8]; unpack8(*(const u32x4*)(h2 + (size_t)row * 1024 + c), v);
            f32x4 g0 = *(const f32x4*)(p.g_final + c), g1 = *(const f32x4*)(p.g_final + c + 4);
            *(f32x4*)(o + c) = (f32x4){v[0] * rinv * g0[0], v[1] * rinv * g0[1], v[2] * rinv * g0[2], v[3] * rinv * g0[3]};
            *(f32x4*)(o + c + 4) = (f32x4){v[4] * rinv * g1[0], v[5] * rinv * g1[1], v[6] * rinv * g1[2], v[7] * rinv * g1[3]};
        }
    }
}

__global__ void __launch_bounds__(NTHR) fwd_kernel(P p, int ph0, int ph1, size_t dbg_off, size_t dbg_bytes) {
    unsigned* bar = (unsigned*)(p.ws + W_BAR);
#define GSYNC(i) do { asm volatile("s_waitcnt vmcnt(0) lgkmcnt(0)" ::: "memory"); __syncthreads(); \
        if (threadIdx.x == 0) { asm volatile("buffer_wbl2 sc1\n\ts_waitcnt vmcnt(0)" ::: "memory"); \
            const unsigned k_ = (unsigned)(i), g_ = blockIdx.x & 7u, ng_ = (gridDim.x + 7u - g_) >> 3, ngroups_ = gridDim.x < 8u ? gridDim.x : 8u; \
            const unsigned o1_ = __hip_atomic_fetch_add(bar + 64 * g_, 1u, __ATOMIC_RELAXED, __HIP_MEMORY_SCOPE_AGENT); \
            if (o1_ + 1u == k_ * ng_) { const unsigned o2_ = __hip_atomic_fetch_add(bar + 64 * 8, 1u, __ATOMIC_RELAXED, __HIP_MEMORY_SCOPE_AGENT); \
                if (o2_ + 1u == k_ * ngroups_) { _Pragma("unroll") for (int q_ = 0; q_ < 8; ++q_) __hip_atomic_store(bar + 640 + 32 * q_, k_, __ATOMIC_RELAXED, __HIP_MEMORY_SCOPE_AGENT); } } \
            while (__hip_atomic_load(bar + 640 + 32 * g_, __ATOMIC_RELAXED, __HIP_MEMORY_SCOPE_AGENT) < k_) __builtin_amdgcn_s_sleep(1); \
            asm volatile("buffer_inv sc1\n\ts_waitcnt vmcnt(0)" ::: "memory"); } \
        __syncthreads(); } while (0)
#define PHASE(i, ...) do { if (ph0 <= (i) && (i) < ph1) { if ((i) > ph0) GSYNC((i) - ph0); __VA_ARGS__ } __builtin_amdgcn_sched_barrier(0); } while (0)
    PHASE(0, phase_prep(p););
    PHASE(1, phase_gemm1a(p);
             { const int rem = (((MR + BM - 1) / BM) * (NA / BM)) % (int)gridDim.x;
               if (rem == 0) prep_transposes(p, 25 * 16, 1440, blockIdx.x, gridDim.x);
               else if ((int)blockIdx.x >= rem) prep_transposes(p, 25 * 16, 1440, blockIdx.x - rem, gridDim.x - rem); });
    PHASE(2, { const int wid = threadIdx.x >> 6;
               if (!SKIP_ATT) for (int t = (gridDim.x - 1 - blockIdx.x) * 8 + wid; t < ATT_TASKS; t += gridDim.x * 8) attn_wave(p, t);
               __syncthreads();
               for (int u = blockIdx.x; u < NGC * 4; u += gridDim.x) ssd1_unit(p, u); });
    PHASE(3, phase_scan(p););
    PHASE(4, for (int u = blockIdx.x; u < NGC * 4; u += gridDim.x) ssd3_unit(p, u););
    PHASE(5, phase_gemm1b(p););
    PHASE(6, phase_gate(p););
    PHASE(7, phase_gemm2(p););
    PHASE(8, phase_gemm3(p););
    PHASE(9, phase_gemm4(p););
    PHASE(10, phase_act(p););
    PHASE(11, phase_gemm5(p););
    PHASE(12, phase_final(p););
    if (dbg_bytes) { GSYNC(ph1 - ph0);
        const u32x4* src = (const u32x4*)(p.ws + dbg_off); u32x4* dst = (u32x4*)(p.out + O_YP);
        for (size_t i = (size_t)blockIdx.x * NTHR + threadIdx.x; i < dbg_bytes / 16; i += (size_t)gridDim.x * NTHR) dst[i] = src[i]; }
}

extern "C" void kernel_launch(void* const* d_in, const int* in_sizes, int n_in, void* d_out, int out_size, void* d_ws, size_t ws_size, hipStream_t stream) {
    (void)in_sizes; (void)n_in; (void)out_size;
    if (ws_size < W_END) { fprintf(stderr, "workspace too small: %zu < %zu\n", ws_size, (size_t)W_END); return; }
    P p{};
    const float** f = (const float**)&p;
    for (int i = 0; i < 25; ++i) f[i] = (const float*)d_in[i];
    p.out = (float*)d_out; p.ws = (char*)d_ws;
    (void)hipFuncSetAttribute((const void*)fwd_kernel, hipFuncAttributeMaxDynamicSharedMemorySize, SMEM_BYTES);
    int dev = 0, cus = 0, per_cu = 0;
    (void)hipGetDevice(&dev);
    (void)hipDeviceGetAttribute(&cus, hipDeviceAttributeMultiprocessorCount, dev);
    (void)hipOccupancyMaxActiveBlocksPerMultiprocessor(&per_cu, fwd_kernel, NTHR, SMEM_BYTES);
    if (per_cu < 1) per_cu = 1;
    int grid = cus * 1;
    size_t dbg_off = 0, dbg_bytes = 0;
    hipError_t e = hipSuccess;
#if SINGLE_LAUNCH
    int ph0 = 0, ph1 = 13;
    void* args[] = {&p, &ph0, &ph1, &dbg_off, &dbg_bytes};
    (void)hipMemsetAsync((char*)d_ws + W_BAR, 0, 4096, stream);
    e = hipLaunchCooperativeKernel((void*)fwd_kernel, dim3(grid), dim3(NTHR), args, SMEM_BYTES, stream);
#else
    for (int ph = 0; ph < NPH && e == hipSuccess; ++ph) {
        hipLaunchKernelGGL(fwd_kernel, dim3(grid), dim3(NTHR), SMEM_BYTES, stream, p, ph, ph + 1, dbg_off, (size_t)0);
        e = hipGetLastError();
    }
    if (NPH < 13) { dbg_off = W_CS; dbg_bytes = 33554432; hipLaunchKernelGGL(fwd_kernel, dim3(grid), dim3(NTHR), SMEM_BYTES, stream, p, 20, 20, dbg_off, dbg_bytes); }
#endif
    if (e != hipSuccess) fprintf(stderr, "cooperative launch failed: %s (grid %d)\n", hipGetErrorString(e), grid);
}
```

```cpp
#define SINGLE_LAUNCH 1
#define GEMM8 1
#define SKIP_ATT 0
#define NPH 13
#include <hip/hip_runtime.h>
#include <hip/hip_cooperative_groups.h>
#include <cstdio>
#include <cstdint>
namespace cg = cooperative_groups;

typedef unsigned short bf16_t;
typedef short bf16x8 __attribute__((ext_vector_type(8)));
typedef float f32x4 __attribute__((ext_vector_type(4)));
typedef unsigned u32x4 __attribute__((ext_vector_type(4)));
typedef unsigned u32x2 __attribute__((ext_vector_type(2)));

constexpr int DM = 1024, NBP = 4, SEQ = 4096, LP = 4112, NP = NBP * LP  , NBS = 32, LS = 16, NS = NBS * LS  ;
constexpr int MR = NP + NS  , PAST = 1040;
constexpr int NCH_P = 65, NGC = NBP * NCH_P + NBS  ;
constexpr int DFF = 2816, DFF2 = 5632, XBC = 3072, SSDW = 2048;
constexpr int NA = 6400  , NB1 = 4096  ;
constexpr float EPS = 1e-6f;
constexpr int NTHR = 512;
constexpr int SMEM_BYTES = 131072;

constexpr size_t O_YP = 0;
constexpr size_t O_YS = O_YP + (size_t)NBP * SEQ * DM;
constexpr size_t O_KP = O_YS + (size_t)NS * DM;
constexpr size_t O_VP = O_KP + (size_t)NP * DM;
constexpr size_t O_SSMP = O_VP + (size_t)NP * DM;
constexpr size_t O_SCP = O_SSMP + (size_t)NBP * 32 * 64 * 128;
constexpr size_t O_FCP = O_SCP + (size_t)NBP * 3 * XBC;
constexpr size_t O_KS = O_FCP + (size_t)NBP * 2 * DFF2;
constexpr size_t O_VS = O_KS + (size_t)NS * DM;
constexpr size_t O_SSMS = O_VS + (size_t)NS * DM;
constexpr size_t O_SCS = O_SSMS + (size_t)NBS * 32 * 64 * 128;
constexpr size_t O_FCS = O_SCS + (size_t)NBS * 3 * XBC;
constexpr size_t O_END = O_FCS + (size_t)NBS * 2 * DFF2;

constexpr size_t al(size_t x) { return (x + 255) & ~(size_t)255; }
constexpr size_t SZ1K = (size_t)MR * 1024 * 2;
constexpr size_t W_WTA = 0;
constexpr size_t W_WTB = W_WTA + (size_t)NA * 1024 * 2;
constexpr size_t W_WA = W_WTB + (size_t)NB1 * 1024 * 2;
constexpr size_t W_WS = W_WA + (size_t)1024 * 1024 * 2;
constexpr size_t W_WO = W_WS + (size_t)1024 * 2048 * 2;
constexpr size_t W_WUP = W_WO + (size_t)1024 * 1024 * 2;
constexpr size_t W_WDN = W_WUP + (size_t)DFF2 * 1024 * 2;
constexpr size_t W_SMALL = W_WDN + (size_t)1024 * DFF * 2;
constexpr size_t W_RSQ1 = W_SMALL;
constexpr size_t W_RSQ2 = W_RSQ1 + al((size_t)MR * 4);
constexpr size_t W_DEC = W_RSQ2 + al((size_t)MR * 4);
constexpr size_t W_BAR = W_DEC + al((size_t)NGC * 32 * 4);
constexpr size_t W_A = W_BAR + 4096;
constexpr size_t W_UB = W_A;
constexpr size_t W_XPRE = W_UB + SZ1K;
constexpr size_t W_DT = W_XPRE + 3 * SZ1K;
constexpr size_t W_C = W_DT + al((size_t)MR * 32 * 4);
constexpr size_t W_QB = W_C;
constexpr size_t W_KB = W_QB + SZ1K;
constexpr size_t W_VB = W_KB + SZ1K;
constexpr size_t W_CS = W_VB + SZ1K;
constexpr size_t SZ_CS = (size_t)NGC * 32 * 8192 * 2;
constexpr size_t W_D = W_CS + al(SZ_CS);
constexpr size_t W_END = W_D + (size_t)(MR + 256) * DFF * 2;
constexpr size_t W_YSSD = W_KB;
constexpr size_t W_ZB = W_XPRE;
constexpr size_t W_MB = W_XPRE + 2 * SZ1K;
constexpr size_t W_GB = W_CS;
constexpr size_t W_MTMP = W_CS + 2 * SZ1K;
constexpr size_t W_H1F = W_A;
constexpr size_t W_H1B = W_A + 2 * SZ1K;
constexpr size_t W_UPB = W_C;
constexpr size_t W_ACT = W_D;
constexpr size_t W_ATT = W_D;
static_assert(W_MTMP + 2 * SZ1K <= W_CS + SZ_CS, "mtmp fits");
static_assert((size_t)MR * DFF2 * 2 <= (W_D - W_C), "upb fits");
static_assert(W_END <= (size_t)545259520, "workspace");

struct P {
    const float *x_prompt, *x_sample, *cache_k, *cache_v, *state_ssm, *state_ssm_conv, *state_ffn_conv, *meta, *g_mix, *w_in,
        *conv_w_ssd, *conv_b_ssd, *dt_bias, *a_log, *d_skip, *g_ssd_norm, *w_br_att, *w_br_ssd, *w_out, *g_ffn, *w_up,
        *conv_w_ffn, *conv_b_ffn, *w_down, *g_final;
    float* out;
    char* ws;
};

extern __shared__ __attribute__((aligned(16))) char smem[];

typedef __bf16 bf16x2_t __attribute__((ext_vector_type(2)));
typedef float f32x2_t __attribute__((ext_vector_type(2)));
__device__ __forceinline__ unsigned pk2(float lo, float hi) { f32x2_t v = {lo, hi}; bf16x2_t b = __builtin_convertvector(v, bf16x2_t); return __builtin_bit_cast(unsigned, b); }
__device__ __forceinline__ bf16_t f2bf(float f) { return (bf16_t)(pk2(f, 0.f) & 0xffffu); }
__device__ __forceinline__ float bf2f(bf16_t b) { return __uint_as_float(((unsigned)b) << 16); }
__device__ __forceinline__ float bflo(unsigned u) { return __uint_as_float(u << 16); }
__device__ __forceinline__ float bfhi(unsigned u) { return __uint_as_float(u & 0xffff0000u); }
__device__ __forceinline__ void unpack8(u32x4 v, float (&o)[8]) {
    o[0] = bflo(v.x); o[1] = bfhi(v.x); o[2] = bflo(v.y); o[3] = bfhi(v.y); o[4] = bflo(v.z); o[5] = bfhi(v.z); o[6] = bflo(v.w); o[7] = bfhi(v.w);
}
__device__ __forceinline__ u32x4 pack8(const float (&o)[8]) { u32x4 v; v.x = pk2(o[0], o[1]); v.y = pk2(o[2], o[3]); v.z = pk2(o[4], o[5]); v.w = pk2(o[6], o[7]); return v; }
__device__ __forceinline__ float softplus_f(float z) { return fmaxf(z, 0.f) + __logf(1.f + __expf(-fabsf(z))); }
__device__ __forceinline__ float silu_f(float x) { return x * __builtin_amdgcn_rcpf(1.f + __expf(-x)); }
__device__ __forceinline__ float sigmoid_f(float x) { return __builtin_amdgcn_rcpf(1.f + __expf(-x)); }
__device__ __forceinline__ float wave_sum(float v) {
#pragma unroll
    for (int o = 32; o > 0; o >>= 1) v += __shfl_xor(v, o);
    return v;
}
__device__ __forceinline__ const float* hrow(const P& p, int row) {
    if (row < NP) { int b = row / LP, t = row - b * LP; return t < 16 ? p.meta + (size_t)t * DM : p.x_prompt + ((size_t)b * SEQ + (t - 16)) * DM; }
    return p.x_sample + (size_t)(row - NP) * DM;
}

constexpr int BM = 256, BK = 64, HALF = 128, HT = HALF * BK;
__device__ __forceinline__ int lds_byte(int r, int c) { int st = (r >> 4) * 2 + (c >> 5), rr = r & 15, cc = c & 31, ob = rr * 64 + cc * 2; return st * 1024 + (ob ^ (((ob >> 9) & 1) << 5)); }
__device__ __forceinline__ void stage_rc(int b, int& R, int& C) { int st = b / 1024, sb = b % 1024, swz = sb ^ (((sb >> 9) & 1) << 5); R = (st >> 1) * 16 + swz / 64; C = (st & 1) * 32 + (swz % 64) / 2; }

#define SHMB ((bf16_t*)smem)
#define SA(b, h) (SHMB + ((b) * 2 + (h)) * HT)
#define SB(b, h) (SHMB + (4 + (b) * 2 + (h)) * HT)
#define STAGE(Pp, BASE, br, kt, KK) do { size_t _g = (size_t)(br) * (KK) + (size_t)(kt) * BK; \
    for (int _i = 0; _i < 2; ++_i) { int _b = threadIdx.x * 16 + _i * 8192; int _r, _c; stage_rc(_b, _r, _c); \
      __builtin_amdgcn_global_load_lds((const unsigned*)((BASE) + _g + (size_t)_r * (KK) + _c), (unsigned*)((char*)(Pp) + _b), 16, 0, 0); } } while (0)
#define LDA(dst, b, h) for (int m = 0; m < 4; ++m) for (int k = 0; k < 2; ++k) \
    dst[m][k] = *reinterpret_cast<const bf16x8*>((char*)SA(b, h) + lds_byte(wr * 64 + m * 16 + fr, k * 32 + fq * 8))
#define LDB(dst, b, h) for (int n = 0; n < 2; ++n) for (int k = 0; k < 2; ++k) \
    dst[n][k] = *reinterpret_cast<const bf16x8*>((char*)SB(b, h) + lds_byte(wc * 32 + n * 16 + fr, k * 32 + fq * 8))
#define MMA(ai, bj, At, Bt) do { __builtin_amdgcn_s_setprio(1); \
    for (int m = 0; m < 4; ++m) for (int n = 0; n < 2; ++n) for (int k = 0; k < 2; ++k) \
      acc[ai][bj][m][n] = __builtin_amdgcn_mfma_f32_16x16x32_bf16(Bt[n][k], At[m][k], acc[ai][bj][m][n], 0, 0, 0); \
    __builtin_amdgcn_s_setprio(0); } while (0)
#define WAIT_V(n) asm volatile("s_waitcnt vmcnt(" #n ")" ::: "memory")
#define WAIT_L(n) asm volatile("s_waitcnt lgkmcnt(" #n ")" ::: "memory")
#define BAR __builtin_amdgcn_s_barrier()

__device__ __forceinline__ void gemm_tile(const bf16_t* __restrict__ A, const bf16_t* __restrict__ Bt, int K, int brow, int bcol, f32x4 (&acc)[2][2][4][2]) {
    const int wid = threadIdx.x >> 6, lane = threadIdx.x & 63, wr = wid >> 2, wc = wid & 3, fr = lane & 15, fq = lane >> 4;
    const int nt = K / BK;
    int so[2];
#pragma unroll
    for (int i = 0; i < 2; ++i) { int r_, c_; stage_rc(threadIdx.x * 16 + i * 8192, r_, c_); so[i] = r_ * K + c_; }
    const bf16_t* Ab = A + (size_t)brow * K; const bf16_t* Bb = Bt + (size_t)bcol * K;
    const int hk = HALF * K;
    char* ldst = smem + threadIdx.x * 16;
#define STG(bufbyte, base, koff) do { \
        __builtin_amdgcn_global_load_lds((const unsigned*)((base) + (koff) + so[0]), (unsigned*)(ldst + (bufbyte)), 16, 0, 0); \
        __builtin_amdgcn_global_load_lds((const unsigned*)((base) + (koff) + so[1]), (unsigned*)(ldst + (bufbyte) + 8192), 16, 0, 0); } while (0)
#define STG_TILE(b, kt) do { const int ko_ = (kt) * BK; \
        STG((4 + (b) * 2 + 0) * 16384, Bb, ko_); STG(((b) * 2 + 0) * 16384, Ab, ko_); \
        STG((4 + (b) * 2 + 1) * 16384, Bb + hk, ko_); STG(((b) * 2 + 1) * 16384, Ab + hk, ko_); } while (0)
    const int sw = (fr * 64 + fq * 16) ^ (((fr >> 3) & 1) << 5);
    const char* la = smem + wr * 8192 + sw;
    const char* lb = smem + 65536 + wc * 4096 + sw;
#define LDA2(dst, b, h) _Pragma("unroll") for (int m = 0; m < 4; ++m) _Pragma("unroll") for (int k = 0; k < 2; ++k) \
        dst[m][k] = *reinterpret_cast<const bf16x8*>(la + ((b) * 2 + (h)) * 16384 + m * 2048 + k * 1024)
#define LDB2(dst, b, h) _Pragma("unroll") for (int n = 0; n < 2; ++n) _Pragma("unroll") for (int k = 0; k < 2; ++k) \
        dst[n][k] = *reinterpret_cast<const bf16x8*>(lb + ((b) * 2 + (h)) * 16384 + n * 2048 + k * 1024)
#define KTILE(b) do { bf16x8 At[4][2], B0[2][2]; \
        LDA2(At, b, 0); LDB2(B0, b, 0); MMA(0, 0, At, B0); LDB2(B0, b, 1); MMA(0, 1, At, B0); \
        LDA2(At, b, 1); MMA(1, 1, At, B0); LDB2(B0, b, 0); MMA(1, 0, At, B0); } while (0)
#if GEMM8
#define STH(bufidx, base, kt) STG((bufidx) * 16384, base, (kt) * BK)
#define SAi(b, h) ((b) * 2 + (h))
#define SBi(b, h) (4 + (b) * 2 + (h))
#define SCHED __builtin_amdgcn_sched_barrier(0)
    {
        bf16x8 At[4][2], B0[2][2], B1[2][2];
        STH(SBi(0, 0), Bb, 0); STH(SAi(0, 0), Ab, 0); STH(SBi(0, 1), Bb + hk, 0); STH(SAi(0, 1), Ab + hk, 0);
        if (wr == 1) BAR;
        WAIT_V(4); BAR;
        STH(SBi(1, 0), Bb, 1); STH(SAi(1, 0), Ab, 1); STH(SBi(1, 1), Bb + hk, 1);
        WAIT_V(6); BAR;
        for (int t = 0; t < nt - 2; t += 2) {
            LDB2(B0, 0, 0); SCHED; LDA2(At, 0, 0); STH(SAi(1, 1), Ab + hk, t + 1);
            WAIT_L(8); BAR; WAIT_L(0); MMA(0, 0, At, B0); BAR; SCHED;
            LDB2(B1, 0, 1); STH(SBi(0, 0), Bb, t + 2);
            BAR; WAIT_L(0); MMA(0, 1, At, B1); BAR;
            LDA2(At, 0, 1); STH(SAi(0, 0), Ab, t + 2);
            BAR; WAIT_L(0); MMA(1, 0, At, B0); BAR; SCHED;
            STH(SBi(0, 1), Bb + hk, t + 2);
            WAIT_V(6); BAR; MMA(1, 1, At, B1); BAR;
            LDB2(B0, 1, 0); SCHED; LDA2(At, 1, 0); STH(SAi(0, 1), Ab + hk, t + 2);
            WAIT_L(8); BAR; WAIT_L(0); MMA(0, 0, At, B0); BAR; SCHED;
            LDB2(B1, 1, 1); STH(SBi(1, 0), Bb, t + 3);
            BAR; WAIT_L(0); MMA(0, 1, At, B1); BAR;
            LDA2(At, 1, 1); STH(SAi(1, 0), Ab, t + 3);
            BAR; WAIT_L(0); MMA(1, 0, At, B0); BAR; SCHED;
            STH(SBi(1, 1), Bb + hk, t + 3);
            WAIT_V(6); BAR; MMA(1, 1, At, B1); BAR;
        }
        { LDB2(B0, 0, 0); LDA2(At, 0, 0); STH(SAi(1, 1), Ab + hk, nt - 1);
          BAR; WAIT_L(0); MMA(0, 0, At, B0); BAR;
          LDB2(B1, 0, 1); BAR; WAIT_L(0); MMA(0, 1, At, B1); BAR;
          LDA2(At, 0, 1); WAIT_V(4); BAR; WAIT_L(0); MMA(1, 0, At, B0); MMA(1, 1, At, B1); BAR; }
        { LDB2(B0, 1, 0); LDA2(At, 1, 0); WAIT_V(2); BAR; WAIT_L(0); MMA(0, 0, At, B0); BAR;
          LDB2(B1, 1, 1); WAIT_V(0); BAR; WAIT_L(0); MMA(0, 1, At, B1); BAR;
          LDA2(At, 1, 1); BAR; WAIT_L(0); MMA(1, 0, At, B0); MMA(1, 1, At, B1); BAR; }
        if (wr == 0) BAR;
    }
#else
    STG_TILE(0, 0);
    for (int t = 0; t < nt; t += 2) {
        STG_TILE(1, t + 1);
        WAIT_V(8); BAR;
        KTILE(0);
        WAIT_L(0); BAR;
        if (t + 2 < nt) { STG_TILE(0, t + 2); WAIT_V(8); } else { WAIT_V(0); }
        BAR;
        KTILE(1);
        WAIT_L(0); BAR;
    }
#endif
}

__device__ __forceinline__ bool tile_next(int L, int nM, int nN, int& pm, int& pn) {
    const int nwg = nM * nN; if (L >= nwg) return false;
    int wgid = L; { const int q = nwg / 8, r = nwg % 8, xcd = wgid % 8, off = wgid / 8; wgid = (xcd < r ? xcd * (q + 1) : r * (q + 1) + (xcd - r) * q) + off; }
    const int WGM = 8, nig = WGM * nN, gid = wgid / nig, fm = gid * WGM, gsz = (nM - fm) < WGM ? (nM - fm) : WGM;
    pm = fm + ((wgid % nig) % gsz); pn = (wgid % nig) / gsz; return true;
}

#define ACC_FOREACH(...) do { \
    _Pragma("unroll") for (int ai = 0; ai < 2; ++ai) _Pragma("unroll") for (int m = 0; m < 4; ++m) { \
      const int row = brow + ai * HALF + wr * 64 + m * 16 + fr; if (row < MR) { \
      _Pragma("unroll") for (int bj = 0; bj < 2; ++bj) _Pragma("unroll") for (int n = 0; n < 2; ++n) { \
        const int col = bcol + bj * HALF + wc * 32 + n * 16 + fq * 4; f32x4 v = acc[ai][bj][m][n]; __VA_ARGS__ } } __builtin_amdgcn_sched_barrier(0); } } while (0)

#define GEMM_IDS const int wid = threadIdx.x >> 6, lane = threadIdx.x & 63, wr = wid >> 2, wc = wid & 3, fr = lane & 15, fq = lane >> 4; (void)wid; (void)lane
#define ZERO_ACC f32x4 acc[2][2][4][2]; _Pragma("unroll") for (int a_ = 0; a_ < 2; ++a_) _Pragma("unroll") for (int b_ = 0; b_ < 2; ++b_) _Pragma("unroll") for (int c_ = 0; c_ < 4; ++c_) _Pragma("unroll") for (int d_ = 0; d_ < 2; ++d_) acc[a_][b_][c_][d_] = (f32x4){0.f, 0.f, 0.f, 0.f}

__device__ __forceinline__ void st_bf4(bf16_t* p, f32x4 v) { u32x2 w; w.x = pk2(v[0], v[1]); w.y = pk2(v[2], v[3]); *(u32x2*)p = w; }

__device__ __forceinline__ void gemm_qtile(const bf16_t* __restrict__ A, const bf16_t* __restrict__ Bt, int K, int brow, int bcol, f32x4 (&accq)[4][2]) {
    const int wid = threadIdx.x >> 6, lane = threadIdx.x & 63, fr = lane & 15, fq = lane >> 4;
    const int nt = K / BK;
    int so[2];
#pragma unroll
    for (int i = 0; i < 2; ++i) { int r_, c_; stage_rc(threadIdx.x * 16 + i * 8192, r_, c_); so[i] = r_ * K + c_; }
    const bf16_t* Ab = A + (size_t)brow * K; const bf16_t* Bb = Bt + (size_t)bcol * K;
    const int hk = HALF * K;
    char* ldst = smem + threadIdx.x * 16;
#define QSTG_TILE(b, kt) do { const int ko_ = (kt) * BK; \
        __builtin_amdgcn_global_load_lds((const unsigned*)(Ab + ko_ + so[0]), (unsigned*)(ldst + ((b) * 2) * 16384), 16, 0, 0); \
        STG((4 + (b) * 2 + 0) * 16384, Bb, ko_); STG((4 + (b) * 2 + 1) * 16384, Bb + hk, ko_); } while (0)
    const int sw = (fr * 64 + fq * 16) ^ (((fr >> 3) & 1) << 5);
    const char* la = smem + sw;
    const char* lb = smem + 65536 + (wid >> 2) * 16384 + (wid & 3) * 4096 + sw;
#define QKTILE(b) do { bf16x8 At[4][2], Bq[2][2]; \
        _Pragma("unroll") for (int m = 0; m < 4; ++m) _Pragma("unroll") for (int k = 0; k < 2; ++k) At[m][k] = *reinterpret_cast<const bf16x8*>(la + ((b) * 2) * 16384 + m * 2048 + k * 1024); \
        _Pragma("unroll") for (int n = 0; n < 2; ++n) _Pragma("unroll") for (int k = 0; k < 2; ++k) Bq[n][k] = *reinterpret_cast<const bf16x8*>(lb + ((b) * 2) * 16384 + n * 2048 + k * 1024); \
        _Pragma("unroll") for (int m = 0; m < 4; ++m) _Pragma("unroll") for (int n = 0; n < 2; ++n) _Pragma("unroll") for (int k = 0; k < 2; ++k) \
            accq[m][n] = __builtin_amdgcn_mfma_f32_16x16x32_bf16(Bq[n][k], At[m][k], accq[m][n], 0, 0, 0); } while (0)
    QSTG_TILE(0, 0);
    for (int t = 0; t < nt; t += 2) {
        QSTG_TILE(1, t + 1);
        WAIT_V(5); BAR;
        QKTILE(0);
        WAIT_L(0); BAR;
        if (t + 2 < nt) { QSTG_TILE(0, t + 2); WAIT_V(5); } else { WAIT_V(0); }
        BAR;
        QKTILE(1);
        WAIT_L(0); BAR;
    }
}

template <class Epi>
__device__ __forceinline__ void gemm_phase(const bf16_t* __restrict__ A, const bf16_t* __restrict__ Bt, int K, int N, const Epi& epi) {
    GEMM_IDS;
    const int nM = (MR + BM - 1) / BM, nN = N / BM, T = nM * nN;
    int F = (T / (int)gridDim.x) * (int)gridDim.x;
    if (T - F > 64) F = T;
    int pm, pn;
    for (int L = blockIdx.x; L < F; L += gridDim.x) {
        tile_next(L, nM, nN, pm, pn);
        const int brow = pm * BM, bcol = pn * BM;
        ZERO_ACC;
        gemm_tile(A, Bt, K, brow, bcol, acc);
#pragma unroll
        for (int ai = 0; ai < 2; ++ai)
#pragma unroll
            for (int m = 0; m < 4; ++m) {
                const int row = brow + ai * HALF + wr * 64 + m * 16 + fr;
                float ss = 0.f;
                if (row < MR) {
#pragma unroll
                    for (int bj = 0; bj < 2; ++bj)
#pragma unroll
                        for (int n = 0; n < 2; ++n) epi.frag(row, bcol + bj * HALF + wc * 32 + n * 16 + fq * 4, acc[ai][bj][m][n], ss);
                }
                if (Epi::ROWSUM) { ss += __shfl_xor(ss, 16); ss += __shfl_xor(ss, 32); if (fq == 0 && row < MR) epi.row_done(row, ss); }
                __builtin_amdgcn_sched_barrier(0);
            }
    }
    __builtin_amdgcn_sched_barrier(0);
    for (int q = blockIdx.x; q < 4 * (T - F); q += gridDim.x) {
        tile_next(F + (q >> 2), nM, nN, pm, pn);
        const int brow = pm * BM + (q & 3) * 64, bcol = pn * BM;
        if (brow >= MR) continue;
        f32x4 accq[4][2];
#pragma unroll
        for (int m = 0; m < 4; ++m) { accq[m][0] = (f32x4){0.f, 0.f, 0.f, 0.f}; accq[m][1] = (f32x4){0.f, 0.f, 0.f, 0.f}; }
        gemm_qtile(A, Bt, K, brow, bcol, accq);
#pragma unroll
        for (int m = 0; m < 4; ++m) {
            const int row = brow + m * 16 + fr;
            float ss = 0.f;
            if (row < MR) {
#pragma unroll
                for (int n = 0; n < 2; ++n) epi.frag(row, bcol + (wid >> 2) * HALF + (wid & 3) * 32 + n * 16 + fq * 4, accq[m][n], ss);
            }
            if (Epi::ROWSUM) { ss += __shfl_xor(ss, 16); ss += __shfl_xor(ss, 32); if (fq == 0 && row < MR) epi.row_done(row, ss); }
            __builtin_amdgcn_sched_barrier(0);
        }
    }
}

__device__ __forceinline__ void phase_gemm1a(const P& p) {
    GEMM_IDS;
    const bf16_t* ub = (const bf16_t*)(p.ws + W_UB); const bf16_t* wt = (const bf16_t*)(p.ws + W_WTA);
    bf16_t* qb = (bf16_t*)(p.ws + W_QB); bf16_t* kb = (bf16_t*)(p.ws + W_KB); bf16_t* vb = (bf16_t*)(p.ws + W_VB);
    bf16_t* xpre = (bf16_t*)(p.ws + W_XPRE); float* dtr = (float*)(p.ws + W_DT);
    const int nM = (MR + BM - 1) / BM, nN = NA / BM;
    int pm, pn;
    for (int L = blockIdx.x; tile_next(L, nM, nN, pm, pn); L += gridDim.x) {
        const int brow = pm * BM, bcol = pn * BM;
        ZERO_ACC;
        gemm_tile(ub, wt, 1024, brow, bcol, acc);
        if (bcol < 1024) {
            ACC_FOREACH({ st_bf4(qb + (size_t)row * 1024 + col, v * 0.125f); });
        } else if (bcol < 3072) {
            const bool isk = bcol < 2048;
            bf16_t* dstb = isk ? kb : vb; const int c0 = isk ? 1024 : 2048;
            ACC_FOREACH({ const int c = col - c0; st_bf4(dstb + (size_t)row * 1024 + c, v);
                float* o = p.out + (row < NP ? (isk ? O_KP : O_VP) + (size_t)row * 1024 : (isk ? O_KS : O_VS) + (size_t)(row - NP) * 1024) + c; *(f32x4*)o = v; });
        } else if (bcol < 6144) {
            ACC_FOREACH({ const int c = col - 3072; st_bf4(xpre + (size_t)row * XBC + c, v);
                if (row < NP) { const int b = row / LP, t = row - b * LP; if (t >= LP - 3) *(f32x4*)(p.out + O_SCP + ((size_t)b * 3 + (t - (LP - 3))) * XBC + c) = v; }
                else { const int r2 = row - NP, b = r2 >> 4, t = r2 & 15; if (t >= LS - 3) *(f32x4*)(p.out + O_SCS + ((size_t)b * 3 + (t - (LS - 3))) * XBC + c) = v; } });
        } else {
            ACC_FOREACH({ const int c = col - 6144; if (c < 32) *(f32x4*)(dtr + (size_t)row * 32 + c) = v; });
        }
    }
}

struct Epi1b { static constexpr bool ROWSUM = false; bf16_t* zb; bf16_t* gb;
    __device__ __forceinline__ void frag(int row, int col, f32x4 v, float&) const {
        const bool isz = col < 2048;
        f32x4 s; s[0] = isz ? v[0] : sigmoid_f(v[0]); s[1] = isz ? v[1] : sigmoid_f(v[1]); s[2] = isz ? v[2] : sigmoid_f(v[2]); s[3] = isz ? v[3] : sigmoid_f(v[3]);
        st_bf4((isz ? zb : gb) + (size_t)row * 2048 + (isz ? col : col - 2048), s); }
    __device__ __forceinline__ void row_done(int, float) const {} };
__device__ __forceinline__ void phase_gemm1b(const P& p) {
    Epi1b e{(bf16_t*)(p.ws + W_ZB), (bf16_t*)(p.ws + W_GB)};
    gemm_phase((const bf16_t*)(p.ws + W_UB), (const bf16_t*)(p.ws + W_WTB), 1024, NB1, e);
}

struct Epi2a { static constexpr bool ROWSUM = false; const bf16_t* gb; bf16_t* mtmp;
    __device__ __forceinline__ void frag(int row, int col, f32x4 v, float&) const {
        u32x2 g = *(const u32x2*)(gb + (size_t)row * 2048 + col);
        f32x4 o; o[0] = v[0] * bflo(g.x); o[1] = v[1] * bfhi(g.x); o[2] = v[2] * bflo(g.y); o[3] = v[3] * bfhi(g.y);
        st_bf4(mtmp + (size_t)row * 1024 + col, o); }
    __device__ __forceinline__ void row_done(int, float) const {} };
struct Epi2b { static constexpr bool ROWSUM = false; const bf16_t* gb; const bf16_t* mtmp; bf16_t* mb;
    __device__ __forceinline__ void frag(int row, int col, f32x4 v, float&) const {
        u32x2 g = *(const u32x2*)(gb + (size_t)row * 2048 + 1024 + col);
        u32x2 mt = *(const u32x2*)(mtmp + (size_t)row * 1024 + col);
        f32x4 o; o[0] = bflo(mt.x) + v[0] * bflo(g.x); o[1] = bfhi(mt.x) + v[1] * bfhi(g.x); o[2] = bflo(mt.y) + v[2] * bflo(g.y); o[3] = bfhi(mt.y) + v[3] * bfhi(g.y);
        st_bf4(mb + (size_t)row * 1024 + col, o); }
    __device__ __forceinline__ void row_done(int, float) const {} };
__device__ __forceinline__ void phase_gemm2(const P& p) {
    Epi2a ea{(const bf16_t*)(p.ws + W_GB), (bf16_t*)(p.ws + W_MTMP)};
    gemm_phase((const bf16_t*)(p.ws + W_ATT), (const bf16_t*)(p.ws + W_WA), 1024, 1024, ea);
    __builtin_amdgcn_sched_barrier(0);
    Epi2b eb{(const bf16_t*)(p.ws + W_GB), (const bf16_t*)(p.ws + W_MTMP), (bf16_t*)(p.ws + W_MB)};
    gemm_phase((const bf16_t*)(p.ws + W_YSSD), (const bf16_t*)(p.ws + W_WS), 2048, 1024, eb);
}

struct Epi3 { static constexpr bool ROWSUM = true; const P* pp; float* h1f; bf16_t* h1b; float* rsq;
    __device__ __forceinline__ void frag(int row, int col, f32x4 a, float& ss) const {
        f32x4 v = a + *(const f32x4*)(hrow(*pp, row) + col);
        *(f32x4*)(h1f + (size_t)row * 1024 + col) = v; st_bf4(h1b + (size_t)row * 1024 + col, v);
        ss += v[0] * v[0] + v[1] * v[1] + v[2] * v[2] + v[3] * v[3]; }
    __device__ __forceinline__ void row_done(int row, float ss) const { atomicAdd(rsq + row, ss); } };
__device__ __forceinline__ void phase_gemm3(const P& p) {
    Epi3 e{&p, (float*)(p.ws + W_H1F), (bf16_t*)(p.ws + W_H1B), (float*)(p.ws + W_RSQ1)};
    gemm_phase((const bf16_t*)(p.ws + W_MB), (const bf16_t*)(p.ws + W_WO), 1024, 1024, e);
}

__device__ __forceinline__ void phase_gemm4(const P& p) {
    GEMM_IDS;
    const bf16_t* h1b = (const bf16_t*)(p.ws + W_H1B); const bf16_t* wup = (const bf16_t*)(p.ws + W_WUP);
    bf16_t* upb = (bf16_t*)(p.ws + W_UPB); const float* rsq = (const float*)(p.ws + W_RSQ1);
    const int nM = (MR + BM - 1) / BM, nN = DFF2 / BM;
    int pm, pn;
    for (int L = blockIdx.x; tile_next(L, nM, nN, pm, pn); L += gridDim.x) {
        const int brow = pm * BM, bcol = pn * BM;
        ZERO_ACC;
        gemm_tile(h1b, wup, 1024, brow, bcol, acc);
#pragma unroll
        for (int ai = 0; ai < 2; ++ai)
#pragma unroll
            for (int m = 0; m < 4; ++m) {
                const int row = brow + ai * HALF + wr * 64 + m * 16 + fr;
                if (row < MR) {
                    const float rinv = rsqrtf(__builtin_nontemporal_load(rsq + row) * (1.f / 1024.f) + EPS);
                    float* fo = nullptr;
                    if (row < NP) { const int b = row / LP, t = row - b * LP; if (t >= LP - 2) fo = p.out + O_FCP + ((size_t)b * 2 + (t - (LP - 2))) * DFF2; }
                    else { const int r2 = row - NP, b = r2 >> 4, t = r2 & 15; if (t >= LS - 2) fo = p.out + O_FCS + ((size_t)b * 2 + (t - (LS - 2))) * DFF2; }
#pragma unroll
                    for (int bj = 0; bj < 2; ++bj)
#pragma unroll
                        for (int n = 0; n < 2; ++n) {
                            const int col = bcol + bj * HALF + wc * 32 + n * 16 + fq * 4;
                            f32x4 v = acc[ai][bj][m][n] * rinv;
                            st_bf4(upb + (size_t)row * DFF2 + col, v);
                            if (fo) *(f32x4*)(fo + col) = v;
                        }
                }
                __builtin_amdgcn_sched_barrier(0);
            }
    }
}

struct Epi5 { static constexpr bool ROWSUM = true; const float* h1f; bf16_t* h2b; float* rsq;
    __device__ __forceinline__ void frag(int row, int col, f32x4 a, float& ss) const {
        f32x4 v = a + *(const f32x4*)(h1f + (size_t)row * 1024 + col); st_bf4(h2b + (size_t)row * 1024 + col, v);
        ss += v[0] * v[0] + v[1] * v[1] + v[2] * v[2] + v[3] * v[3]; }
    __device__ __forceinline__ void row_done(int row, float ss) const { atomicAdd(rsq + row, ss); } };
__device__ __forceinline__ void phase_gemm5(const P& p) {
    Epi5 e{(const float*)(p.ws + W_H1F), (bf16_t*)(p.ws + W_H1B), (float*)(p.ws + W_RSQ2)};
    gemm_phase((const bf16_t*)(p.ws + W_ACT), (const bf16_t*)(p.ws + W_WDN), DFF, 1024, e);
}

__device__ __forceinline__ void tr_tile(const float* __restrict__ src, int sstride, bf16_t* __restrict__ dst, int K, int n0, int k0, int mode, const float* __restrict__ scale) {
    float* tile = (float*)smem;
    const int tid = threadIdx.x;
    {
        const int kk = tid >> 6, n4 = (tid & 63) * 4;
        const int n = n0 + n4; int sc = n;
        if (mode == 1) sc = n < 3072 ? n : (n < 6176 ? n + 2048 : -1);
        else if (mode == 2) sc = n < 2048 ? n + 3072 : n + 6176;
        f32x4 v[8];
#pragma unroll
        for (int i = 0; i < 8; ++i) {
            const int k = kk + 8 * i;
            v[i] = (f32x4){0.f, 0.f, 0.f, 0.f};
            if (sc >= 0) v[i] = *(const f32x4*)(src + (size_t)(k0 + k) * sstride + sc);
            if (scale) v[i] = v[i] * scale[k0 + k];
        }
#pragma unroll
        for (int i = 0; i < 8; ++i) { const int k = kk + 8 * i;
            tile[k * 257 + n4 + 0] = v[i][0]; tile[k * 257 + n4 + 1] = v[i][1]; tile[k * 257 + n4 + 2] = v[i][2]; tile[k * 257 + n4 + 3] = v[i][3]; }
    }
    __syncthreads();
    {
        const int n = tid >> 1, k32 = (tid & 1) * 32;
#pragma unroll
        for (int q = 0; q < 4; ++q) {
            float o[8];
#pragma unroll
            for (int j = 0; j < 8; ++j) o[j] = tile[(k32 + q * 8 + j) * 257 + n];
            *(u32x4*)(dst + (size_t)(n0 + n) * K + k0 + k32 + q * 8) = pack8(o);
        }
    }
    __syncthreads();
}

__device__ __forceinline__ void prep_transposes(const P& p, int it0, int it1, int rank, int nrank) {
    const int cnt[7] = {25 * 16, 16 * 16, 4 * 16, 4 * 32, 4 * 16, 22 * 16, 4 * 44};
    for (int it = it0 + rank; it < it1; it += nrank) {
        int m = 0, r = it;
#pragma unroll
        for (int i = 0; i < 6; ++i) if (m == i && r >= cnt[i]) { r -= cnt[i]; m = i + 1; }
        const float* src; int sstride, K, kT, mode = 0; size_t woff; const float* scale = nullptr;
        switch (m) {
            case 0: src = p.w_in; sstride = 10272; K = 1024; kT = 16; mode = 1; woff = W_WTA; break;
            case 1: src = p.w_in; sstride = 10272; K = 1024; kT = 16; mode = 2; woff = W_WTB; break;
            case 2: src = p.w_br_att; sstride = 1024; K = 1024; kT = 16; woff = W_WA; break;
            case 3: src = p.w_br_ssd; sstride = 1024; K = 2048; kT = 32; woff = W_WS; break;
            case 4: src = p.w_out; sstride = 1024; K = 1024; kT = 16; woff = W_WO; break;
            case 5: src = p.w_up; sstride = DFF2; K = 1024; kT = 16; woff = W_WUP; scale = p.g_ffn; break;
            default: src = p.w_down; sstride = 1024; K = DFF; kT = 44; woff = W_WDN; break;
        }
        const int nt = r / kT, kt = r - nt * kT;
        tr_tile(src, sstride, (bf16_t*)(p.ws + woff), K, nt * 256, kt * 64, mode, scale);
    }
}

__device__ __forceinline__ void phase_prep(const P& p) {
    prep_transposes(p, 0, 25 * 16, blockIdx.x, gridDim.x);
    const int wid = threadIdx.x >> 6, lane = threadIdx.x & 63;
    bf16_t* ub = (bf16_t*)(p.ws + W_UB);
    for (int row = blockIdx.x * 8 + wid; row < MR; row += gridDim.x * 8) {
        const float* hr = hrow(p, row);
        f32x4 v[4]; float ss = 0.f;
#pragma unroll
        for (int i = 0; i < 4; ++i) { v[i] = *(const f32x4*)(hr + i * 256 + lane * 4); ss += v[i][0] * v[i][0] + v[i][1] * v[i][1] + v[i][2] * v[i][2] + v[i][3] * v[i][3]; }
        ss = wave_sum(ss);
        const float rinv = rsqrtf(ss * (1.f / 1024.f) + EPS);
#pragma unroll
        for (int i = 0; i < 4; ++i) { f32x4 g = *(const f32x4*)(p.g_mix + i * 256 + lane * 4); st_bf4(ub + (size_t)row * 1024 + i * 256 + lane * 4, v[i] * rinv * g); }
    }
    float* r1 = (float*)(p.ws + W_RSQ1); float* r2 = (float*)(p.ws + W_RSQ2);
    for (int i = blockIdx.x * NTHR + threadIdx.x; i < MR; i += gridDim.x * NTHR) { r1[i] = 0.f; r2[i] = 0.f; }
}

template <bool SAMPLE, bool ISV>
__device__ __forceinline__ u32x4 kv_load8(const P& p, int seqrow0, int bs, int h, int key, int d0) {
    if (!SAMPLE) {
        const bf16_t* base = (const bf16_t*)(p.ws + (ISV ? W_VB : W_KB));
        return *(const u32x4*)(base + (size_t)(seqrow0 + key) * 1024 + h * 64 + d0);
    } else {
        if (key < PAST) {
            const float* src = (ISV ? p.cache_v : p.cache_k) + ((size_t)bs * PAST + key) * 1024 + h * 64 + d0;
            f32x4 a = *(const f32x4*)src, b = *(const f32x4*)(src + 4);
            u32x4 r; r.x = pk2(a[0], a[1]); r.y = pk2(a[2], a[3]); r.z = pk2(b[0], b[1]); r.w = pk2(b[2], b[3]); return r;
        } else if (key < PAST + LS) {
            const bf16_t* base = (const bf16_t*)(p.ws + (ISV ? W_VB : W_KB));
            return *(const u32x4*)(base + (size_t)(seqrow0 + (key - PAST)) * 1024 + h * 64 + d0);
        }
        return (u32x4){0u, 0u, 0u, 0u};
    }
}

template <bool SAMPLE, int NT>
__device__ __forceinline__ void attn_task(const P& p, int seqrow0  , int bs, int h, int q0  , int qrow0  , int ntile_valid, bf16_t* vt  ) {
    const int lane = threadIdx.x & 63, fr = lane & 15, fq = lane >> 4;
    bf16_t* qb = (bf16_t*)(p.ws + W_QB);
    bf16x8 qf0[NT], qf1[NT];
#pragma unroll
    for (int u = 0; u < NT; ++u) { const bf16_t* qp = qb + (size_t)(qrow0 + u * 16 + fr) * 1024 + h * 64 + fq * 8; qf0[u] = *(const bf16x8*)qp; qf1[u] = *(const bf16x8*)(qp + 32); }
    f32x4 o[NT][4];
    float Pc[NT];
#pragma unroll
    for (int u = 0; u < NT; ++u) { Pc[u] = 1.f;
#pragma unroll
        for (int i = 0; i < 4; ++i) o[u][i] = (f32x4){0.f, 0.f, 0.f, 0.f}; }
    const int kb0 = (q0 + 16 * (NT - 1) + 14) >> 6;
    u32x4 Kc[4][2], Vc[8];
#pragma unroll
    for (int kt = 0; kt < 4; ++kt) { const int key = kb0 * 64 + kt * 16 + fr; Kc[kt][0] = kv_load8<SAMPLE, false>(p, seqrow0, bs, h, key, fq * 8); Kc[kt][1] = kv_load8<SAMPLE, false>(p, seqrow0, bs, h, key, 32 + fq * 8); }
    const int vkr = lane & 7, vdc = lane >> 3;
#pragma unroll
    for (int i = 0; i < 8; ++i) Vc[i] = kv_load8<SAMPLE, true>(p, seqrow0, bs, h, kb0 * 64 + vkr * 8 + i, vdc * 8);
    for (int kb = kb0; kb >= 0; --kb) {
        f32x4 zt[NT][4];
#pragma unroll
        for (int kt = 0; kt < 4; ++kt)
#pragma unroll
            for (int u = 0; u < NT; ++u) {
                f32x4 a = (f32x4){0.f, 0.f, 0.f, 0.f};
                a = __builtin_amdgcn_mfma_f32_16x16x32_bf16(__builtin_bit_cast(bf16x8, Kc[kt][0]), qf0[u], a, 0, 0, 0);
                a = __builtin_amdgcn_mfma_f32_16x16x32_bf16(__builtin_bit_cast(bf16x8, Kc[kt][1]), qf1[u], a, 0, 0, 0);
                zt[u][kt] = a;
            }
#pragma unroll
        for (int jp = 0; jp < 4; ++jp) {
            u32x4 lo, hi;
            lo.x = (Vc[0][jp] & 0xffffu) | (Vc[1][jp] << 16); lo.y = (Vc[2][jp] & 0xffffu) | (Vc[3][jp] << 16); lo.z = (Vc[4][jp] & 0xffffu) | (Vc[5][jp] << 16); lo.w = (Vc[6][jp] & 0xffffu) | (Vc[7][jp] << 16);
            hi.x = (Vc[0][jp] >> 16) | (Vc[1][jp] & 0xffff0000u); hi.y = (Vc[2][jp] >> 16) | (Vc[3][jp] & 0xffff0000u); hi.z = (Vc[4][jp] >> 16) | (Vc[5][jp] & 0xffff0000u); hi.w = (Vc[6][jp] >> 16) | (Vc[7][jp] & 0xffff0000u);
            *(u32x4*)(vt + (vdc * 8 + 2 * jp) * 72 + vkr * 8) = lo;
            *(u32x4*)(vt + (vdc * 8 + 2 * jp + 1) * 72 + vkr * 8) = hi;
        }
        if (kb > 0) {
#pragma unroll
            for (int kt = 0; kt < 4; ++kt) { const int key = (kb - 1) * 64 + kt * 16 + fr; Kc[kt][0] = kv_load8<SAMPLE, false>(p, seqrow0, bs, h, key, fq * 8); Kc[kt][1] = kv_load8<SAMPLE, false>(p, seqrow0, bs, h, key, 32 + fq * 8); }
#pragma unroll
            for (int i = 0; i < 8; ++i) Vc[i] = kv_load8<SAMPLE, true>(p, seqrow0, bs, h, (kb - 1) * 64 + vkr * 8 + i, vdc * 8);
        }
        u32x4 wf[NT][2];
#pragma unroll
        for (int u = 0; u < NT; ++u) {
            const int qpos = q0 + u * 16 + fr;
            float kp[4][4], run[4], above[4], tot[4];
#pragma unroll
            for (int kt = 0; kt < 4; ++kt) {
                run[kt] = 1.f;
#pragma unroll
                for (int r = 0; r < 4; ++r) {
                    const int key = kb * 64 + kt * 16 + fq * 4 + r;
                    const bool v = key < qpos;
                    const float e = __expf(fminf(zt[u][kt][r], 80.f)); const float rt = __builtin_amdgcn_rcpf(1.f + e);
                    kp[kt][r] = v ? rt : 1.f; run[kt] *= kp[kt][r];
                }
                const float a1 = __shfl_down(run[kt], 16), a2 = __shfl_down(run[kt], 32), a3 = __shfl_down(run[kt], 48);
                above[kt] = (fq < 3 ? a1 : 1.f) * (fq < 2 ? a2 : 1.f) * (fq < 1 ? a3 : 1.f);
                tot[kt] = __shfl(run[kt] * above[kt], fr);
            }
            float later = Pc[u]; float w[4][4];
#pragma unroll
            for (int kt = 3; kt >= 0; --kt) {
                const float base = above[kt] * later; float s3 = 1.f;
#pragma unroll
                for (int r = 3; r >= 0; --r) { w[kt][r] = (1.f - kp[kt][r]) * (s3 * base); s3 *= kp[kt][r]; }
                later *= tot[kt];
            }
            Pc[u] = later;
#pragma unroll
            for (int ks = 0; ks < 2; ++ks) { wf[u][ks].x = pk2(w[2 * ks][0], w[2 * ks][1]); wf[u][ks].y = pk2(w[2 * ks][2], w[2 * ks][3]); wf[u][ks].z = pk2(w[2 * ks + 1][0], w[2 * ks + 1][1]); wf[u][ks].w = pk2(w[2 * ks + 1][2], w[2 * ks + 1][3]); }
        }
        asm volatile("s_waitcnt lgkmcnt(0)" ::: "memory");
        __builtin_amdgcn_wave_barrier();
#pragma unroll
        for (int ks = 0; ks < 2; ++ks) {
#pragma unroll
            for (int dt = 0; dt < 4; ++dt) {
                const bf16_t* vp = vt + (dt * 16 + fr) * 72 + ks * 32 + fq * 4;
                u32x2 lo = *(const u32x2*)vp, hi = *(const u32x2*)(vp + 16);
                u32x4 vf; vf.x = lo.x; vf.y = lo.y; vf.z = hi.x; vf.w = hi.y;
#pragma unroll
                for (int u = 0; u < NT; ++u) o[u][dt] = __builtin_amdgcn_mfma_f32_16x16x32_bf16(__builtin_bit_cast(bf16x8, vf), __builtin_bit_cast(bf16x8, wf[u][ks]), o[u][dt], 0, 0, 0);
            }
        }
        asm volatile("s_waitcnt lgkmcnt(0)" ::: "memory");
        __builtin_amdgcn_wave_barrier();
        bool done = Pc[0] < 1e-37f;
#pragma unroll
        for (int u = 1; u < NT; ++u) done = done && (Pc[u] < 1e-37f);
        if (__all(done)) break;
    }
    bf16_t* attb = (bf16_t*)(p.ws + W_ATT);
#pragma unroll
    for (int u = 0; u < NT; ++u) if (u < ntile_valid) {
#pragma unroll
        for (int dt = 0; dt < 4; ++dt) st_bf4(attb + (size_t)(qrow0 + u * 16 + fr) * 1024 + h * 64 + dt * 16 + fq * 4, o[u][dt]);
    }
}

constexpr int ATT_TASKS_PAIR = NBP * 16 * 128, ATT_TASKS_P = ATT_TASKS_PAIR + NBP * 16, ATT_TASKS = ATT_TASKS_P + NBS * 16;
__device__ __forceinline__ void attn_wave(const P& p, int task) {
    const int wid = threadIdx.x >> 6;
    bf16_t* vt = (bf16_t*)smem + wid * (64 * 72);
    if (task < ATT_TASKS_PAIR) {
        const int pr = task & 127, bh = task >> 7, h = bh & 15, b = bh >> 4;
        attn_task<false, 2>(p, b * LP, b, h, pr * 32, b * LP + pr * 32, 2, vt);
    } else if (task < ATT_TASKS_P) {
        const int bh = task - ATT_TASKS_PAIR, h = bh & 15, b = bh >> 4;
        attn_task<false, 1>(p, b * LP, b, h, 4096, b * LP + 4096, 1, vt);
    } else if (task < ATT_TASKS) {
        const int s = task - ATT_TASKS_P, b = s >> 4, h = s & 15;
        attn_task<true, 1>(p, NP + b * LS, b, h, PAST, NP + b * LS, 1, vt);
    }
}

struct ChunkInfo { int rowbase, L, pad, c, sb; };
__device__ __forceinline__ ChunkInfo chunk_info(int gc) {
    ChunkInfo ci;
    if (gc < NBP * NCH_P) { ci.sb = gc / NCH_P; ci.c = gc - ci.sb * NCH_P; ci.rowbase = ci.sb * LP; ci.L = LP; ci.pad = 48; }
    else { ci.sb = 4 + (gc - NBP * NCH_P); ci.c = 0; ci.rowbase = NP + (gc - NBP * NCH_P) * LS; ci.L = LS; ci.pad = 0; }
    return ci;
}
__device__ __forceinline__ void conv_ssd8(const P& p, const ChunkInfo& ci, int t, int ch0, float (&o)[8]) {
    const bf16_t* xpre = (const bf16_t*)(p.ws + W_XPRE);
    float acc[8];
    { f32x4 b0 = *(const f32x4*)(p.conv_b_ssd + ch0), b1 = *(const f32x4*)(p.conv_b_ssd + ch0 + 4);
      acc[0] = b0[0]; acc[1] = b0[1]; acc[2] = b0[2]; acc[3] = b0[3]; acc[4] = b1[0]; acc[5] = b1[1]; acc[6] = b1[2]; acc[7] = b1[3]; }
#pragma unroll
    for (int i = 0; i < 4; ++i) {
        const int tt = t - 3 + i;
        float x[8];
        if (tt >= 0) { u32x4 v = *(const u32x4*)(xpre + (size_t)(ci.rowbase + tt) * XBC + ch0); unpack8(v, x); }
        else if (ci.sb >= 4) { const float* s = p.state_ssm_conv + ((size_t)(ci.sb - 4) * 3 + (3 + tt)) * XBC + ch0; f32x4 a = *(const f32x4*)s, b = *(const f32x4*)(s + 4);
            x[0] = a[0]; x[1] = a[1]; x[2] = a[2]; x[3] = a[3]; x[4] = b[0]; x[5] = b[1]; x[6] = b[2]; x[7] = b[3]; }
        else {
#pragma unroll
            for (int j = 0; j < 8; ++j) x[j] = 0.f; }
        const float* wp = p.conv_w_ssd + (size_t)i * XBC + ch0; f32x4 w0 = *(const f32x4*)wp, w1 = *(const f32x4*)(wp + 4);
        acc[0] += w0[0] * x[0]; acc[1] += w0[1] * x[1]; acc[2] += w0[2] * x[2]; acc[3] += w0[3] * x[3];
        acc[4] += w1[0] * x[4]; acc[5] += w1[1] * x[5]; acc[6] += w1[2] * x[6]; acc[7] += w1[3] * x[7];
    }
#pragma unroll
    for (int j = 0; j < 8; ++j) o[j] = silu_f(acc[j]);
}
struct XPre { u32x4 r[4]; f32x4 w[4][2]; f32x4 b[2]; };
__device__ __forceinline__ void xpre_load(const P& p, const ChunkInfo& ci, int t, bool valid, int ch0, XPre& x) {
    const bf16_t* xpre = (const bf16_t*)(p.ws + W_XPRE);
#pragma unroll
    for (int i = 0; i < 4; ++i) {
        const int tt = t - 3 + i;
        x.r[i] = (u32x4){0u, 0u, 0u, 0u};
        if (valid) {
            if (tt >= 0) x.r[i] = *(const u32x4*)(xpre + (size_t)(ci.rowbase + tt) * XBC + ch0);
            else if (ci.sb >= 4) { const float* s = p.state_ssm_conv + ((size_t)(ci.sb - 4) * 3 + (3 + tt)) * XBC + ch0; f32x4 a = *(const f32x4*)s, b = *(const f32x4*)(s + 4);
                x.r[i].x = pk2(a[0], a[1]); x.r[i].y = pk2(a[2], a[3]); x.r[i].z = pk2(b[0], b[1]); x.r[i].w = pk2(b[2], b[3]); }
        }
        const float* wp = p.conv_w_ssd + (size_t)i * XBC + ch0; x.w[i][0] = *(const f32x4*)wp; x.w[i][1] = *(const f32x4*)(wp + 4);
    }
    x.b[0] = *(const f32x4*)(p.conv_b_ssd + ch0); x.b[1] = *(const f32x4*)(p.conv_b_ssd + ch0 + 4);
}
__device__ __forceinline__ void xpre_compute(const XPre& x, bool valid, float (&o)[8]) {
    float acc[8] = {x.b[0][0], x.b[0][1], x.b[0][2], x.b[0][3], x.b[1][0], x.b[1][1], x.b[1][2], x.b[1][3]};
#pragma unroll
    for (int i = 0; i < 4; ++i) {
        float v[8]; unpack8(x.r[i], v);
        acc[0] += x.w[i][0][0] * v[0]; acc[1] += x.w[i][0][1] * v[1]; acc[2] += x.w[i][0][2] * v[2]; acc[3] += x.w[i][0][3] * v[3];
        acc[4] += x.w[i][1][0] * v[4]; acc[5] += x.w[i][1][1] * v[5]; acc[6] += x.w[i][1][2] * v[6]; acc[7] += x.w[i][1][3] * v[7];
    }
#pragma unroll
    for (int j = 0; j < 8; ++j) o[j] = valid ? silu_f(acc[j]) : 0.f;
}
__device__ __forceinline__ void chunk_dt(const P& p, const ChunkInfo& ci, int h, int lane, float& dtv, float& acum, float& alast) {
    const float* dtr = (const float*)(p.ws + W_DT);
    const int t = ci.c * 64 + lane - ci.pad; const bool valid = t >= 0 && t < ci.L;
    dtv = 0.f;
    if (valid) { const float x = dtr[(size_t)(ci.rowbase + t) * 32 + h] + p.dt_bias[h]; const float e = __expf(-fabsf(x));
        dtv = fmaxf(x, 0.f) + (e < 0.01f ? e * (1.f - e * (0.5f - e * 0.33333334f)) : __logf(1.f + e)); }
    const float a = -__expf(p.a_log[h]);
    float x = dtv * a;
#pragma unroll
    for (int off = 1; off < 64; off <<= 1) { const float y = __shfl_up(x, off); if (lane >= off) x += y; }
    acum = x; alast = __shfl(x, 63);
}

__device__ __forceinline__ void wave_xtile(const P& p, const ChunkInfo& ci, int h, int lane, bf16_t* xtw, const float* te) {
    const bf16_t* xpre = (const bf16_t*)(p.ws + W_XPRE);
    const int chunk = lane & 7, s0 = (lane >> 3) * 8, ch0 = h * 64 + chunk * 8;
    const int tok0 = ci.c * 64 + s0 - ci.pad;
    u32x4 rows[11];
#pragma unroll
    for (int i = 0; i < 11; ++i) {
        const int tt = tok0 - 3 + i;
        rows[i] = (u32x4){0u, 0u, 0u, 0u};
        if (tt >= 0 && tt < ci.L) rows[i] = *(const u32x4*)(xpre + (size_t)(ci.rowbase + tt) * XBC + ch0);
        else if (tt < 0 && tt >= -3 && ci.sb >= 4) { const float* sp_ = p.state_ssm_conv + ((size_t)(ci.sb - 4) * 3 + (3 + tt)) * XBC + ch0; f32x4 a = *(const f32x4*)sp_, b = *(const f32x4*)(sp_ + 4);
            rows[i].x = pk2(a[0], a[1]); rows[i].y = pk2(a[2], a[3]); rows[i].z = pk2(b[0], b[1]); rows[i].w = pk2(b[2], b[3]); }
    }
    float w[4][8], bias[8];
#pragma unroll
    for (int i = 0; i < 4; ++i) { const float* wp = p.conv_w_ssd + (size_t)i * XBC + ch0; f32x4 a = *(const f32x4*)wp, b = *(const f32x4*)(wp + 4);
        w[i][0] = a[0]; w[i][1] = a[1]; w[i][2] = a[2]; w[i][3] = a[3]; w[i][4] = b[0]; w[i][5] = b[1]; w[i][6] = b[2]; w[i][7] = b[3]; }
    { f32x4 a = *(const f32x4*)(p.conv_b_ssd + ch0), b = *(const f32x4*)(p.conv_b_ssd + ch0 + 4);
      bias[0] = a[0]; bias[1] = a[1]; bias[2] = a[2]; bias[3] = a[3]; bias[4] = b[0]; bias[5] = b[1]; bias[6] = b[2]; bias[7] = b[3]; }
    unsigned pk[8][4];
#pragma unroll
    for (int tp = 0; tp < 4; ++tp) {
        float o[2][8];
#pragma unroll
        for (int e = 0; e < 2; ++e) {
            const int ti = tp * 2 + e;
            const int tok = tok0 + ti; const bool valid = tok >= 0 && tok < ci.L;
            float acc[8];
#pragma unroll
            for (int j = 0; j < 8; ++j) acc[j] = bias[j];
#pragma unroll
            for (int i = 0; i < 4; ++i) { float v[8]; unpack8(rows[ti + i], v);
#pragma unroll
                for (int j = 0; j < 8; ++j) acc[j] += w[i][j] * v[j]; }
            const float sc = te ? te[s0 + ti] : 1.f;
#pragma unroll
            for (int j = 0; j < 8; ++j) o[e][j] = valid ? silu_f(acc[j]) * sc : 0.f;
        }
#pragma unroll
        for (int j = 0; j < 8; ++j) pk[j][tp] = pk2(o[0][j], o[1][j]);
    }
#pragma unroll
    for (int j = 0; j < 8; ++j) { u32x4 v; v.x = pk[j][0]; v.y = pk[j][1]; v.z = pk[j][2]; v.w = pk[j][3]; *(u32x4*)(xtw + (chunk * 8 + j) * 72 + s0) = v; }
    asm volatile("s_waitcnt lgkmcnt(0)" ::: "memory");
    __builtin_amdgcn_wave_barrier();
}

__device__ __forceinline__ void ssd1_unit(const P& p, int unit) {
    const int gc = unit >> 2, g = unit & 3;
    const ChunkInfo ci = chunk_info(gc);
    const int tid = threadIdx.x, wid = tid >> 6, lane = tid & 63, fr = lane & 15, fq = lane >> 4;
    float* toend = (float*)smem;
    bf16_t* BT = (bf16_t*)(smem + 2048);
    bf16_t* XT = (bf16_t*)(smem + 2048 + 128 * 72 * 2);
    bf16_t* cs = (bf16_t*)(p.ws + W_CS); float* dec = (float*)(p.ws + W_DEC);
    {
        float dtv, acum, alast; chunk_dt(p, ci, g * 8 + wid, lane, dtv, acum, alast);
        toend[wid * 64 + lane] = __expf(alast - acum) * dtv;
        if (lane == 0) dec[gc * 32 + g * 8 + wid] = __expf(alast);
    }
#pragma unroll
    for (int i = 0; i < 2; ++i) {
        const int item = tid + 512 * i, s = item >> 4, chunk = item & 15;
        const int t = ci.c * 64 + s - ci.pad; float o[8];
        if (t >= 0 && t < ci.L) conv_ssd8(p, ci, t, SSDW + g * 128 + chunk * 8, o);
        else {
#pragma unroll
            for (int j = 0; j < 8; ++j) o[j] = 0.f; }
#pragma unroll
        for (int j = 0; j < 8; ++j) BT[(chunk * 8 + j) * 72 + s] = f2bf(o[j]);
    }
    __syncthreads();
    {
        const int h = g * 8 + wid;
        bf16_t* xt = XT + wid * (64 * 72);
        wave_xtile(p, ci, h, lane, xt, toend + wid * 64);
        bf16x8 xf[4][2];
#pragma unroll
        for (int pt = 0; pt < 4; ++pt)
#pragma unroll
            for (int ks = 0; ks < 2; ++ks) xf[pt][ks] = *(const bf16x8*)(xt + (pt * 16 + fr) * 72 + ks * 32 + fq * 8);
#pragma unroll
        for (int nt = 0; nt < 8; ++nt) {
            bf16x8 bfr[2];
#pragma unroll
            for (int ks = 0; ks < 2; ++ks) bfr[ks] = *(const bf16x8*)(BT + (nt * 16 + fr) * 72 + ks * 32 + fq * 8);
#pragma unroll
            for (int pt = 0; pt < 4; ++pt) {
                f32x4 a = (f32x4){0.f, 0.f, 0.f, 0.f};
#pragma unroll
                for (int ks = 0; ks < 2; ++ks) a = __builtin_amdgcn_mfma_f32_16x16x32_bf16(bfr[ks], xf[pt][ks], a, 0, 0, 0);
                st_bf4(cs + (((size_t)gc * 32 + h) * 64 + pt * 16 + fr) * 128 + nt * 16 + fq * 4, a);
            }
        }
    }
    __syncthreads();
}

__device__ __forceinline__ void phase_scan(const P& p) {
    bf16_t* cs = (bf16_t*)(p.ws + W_CS); const float* dec = (const float*)(p.ws + W_DEC);
    const int gsz = gridDim.x * NTHR;
    for (int T = blockIdx.x * NTHR + threadIdx.x; T < NBP * 32 * 1024; T += gsz) {
        const int b = T >> 15, rem = T & 32767, h = rem >> 10, pn8 = rem & 1023;
        float st[8];
#pragma unroll
        for (int j = 0; j < 8; ++j) st[j] = 0.f;
        for (int c0 = 0; c0 < NCH_P; c0 += 13) {
            u32x4 v[13]; float d[13];
#pragma unroll
            for (int i = 0; i < 13; ++i) { const int gc = b * NCH_P + c0 + i; v[i] = __builtin_nontemporal_load((const u32x4*)(cs + ((size_t)gc * 32 + h) * 8192 + pn8 * 8)); d[i] = dec[gc * 32 + h]; }
#pragma unroll
            for (int i = 0; i < 13; ++i) {
                const int gc = b * NCH_P + c0 + i; float x[8]; unpack8(v[i], x);
                *(u32x4*)(cs + ((size_t)gc * 32 + h) * 8192 + pn8 * 8) = pack8(st);
#pragma unroll
                for (int j = 0; j < 8; ++j) st[j] = d[i] * st[j] + x[j];
            }
        }
        float* o = p.out + O_SSMP + ((size_t)b * 32 + h) * 8192 + pn8 * 8;
#ifdef SANITIZE
#pragma unroll
        for (int j = 0; j < 8; ++j) if (!(fabsf(st[j]) < 1e30f)) st[j] = 777.f;
#endif
        *(f32x4*)o = (f32x4){st[0], st[1], st[2], st[3]}; *(f32x4*)(o + 4) = (f32x4){st[4], st[5], st[6], st[7]};
    }
    for (int T0 = blockIdx.x * NTHR + threadIdx.x; T0 < NBS * 32 * 1024; T0 += gsz * 4) {
        f32x4 sa[4], sc[4]; u32x4 xv[4]; float dd[4];
#pragma unroll
        for (int i = 0; i < 4; ++i) { const int T = T0 + i * gsz; if (T < NBS * 32 * 1024) {
            const int b = T >> 15, rem = T & 32767, h = rem >> 10, pn8 = rem & 1023; const int gc = NBP * NCH_P + b;
            const float* s0 = p.state_ssm + ((size_t)b * 32 + h) * 8192 + pn8 * 8;
            sa[i] = *(const f32x4*)s0; sc[i] = *(const f32x4*)(s0 + 4);
            xv[i] = *(const u32x4*)(cs + ((size_t)gc * 32 + h) * 8192 + pn8 * 8); dd[i] = dec[gc * 32 + h]; } }
#pragma unroll
        for (int i = 0; i < 4; ++i) { const int T = T0 + i * gsz; if (T < NBS * 32 * 1024) {
            const int b = T >> 15, rem = T & 32767, h = rem >> 10, pn8 = rem & 1023; const int gc = NBP * NCH_P + b;
            float st[8] = {sa[i][0], sa[i][1], sa[i][2], sa[i][3], sc[i][0], sc[i][1], sc[i][2], sc[i][3]};
            float x[8]; unpack8(xv[i], x);
            *(u32x4*)(cs + ((size_t)gc * 32 + h) * 8192 + pn8 * 8) = pack8(st);
            const float d = dd[i];
            float* o = p.out + O_SSMS + ((size_t)b * 32 + h) * 8192 + pn8 * 8;
            *(f32x4*)o = (f32x4){d * st[0] + x[0], d * st[1] + x[1], d * st[2] + x[2], d * st[3] + x[3]};
            *(f32x4*)(o + 4) = (f32x4){d * st[4] + x[4], d * st[5] + x[5], d * st[6] + x[6], d * st[7] + x[7]}; } }
    }
}

__device__ __forceinline__ void ssd3_unit(const P& p, int unit) {
    const int gc = unit >> 2, g = unit & 3;
    const ChunkInfo ci = chunk_info(gc);
    const int tid = threadIdx.x, wid = tid >> 6, lane = tid & 63, fr = lane & 15, fq = lane >> 4;
    float* acl = (float*)smem;
    float* dtl = (float*)(smem + 2048);
    bf16_t* Cs = (bf16_t*)(smem + 4096);
    bf16_t* Bs = (bf16_t*)(smem + 21504);
    float* CB = (float*)(smem + 38912);
    bf16_t* XT = (bf16_t*)(smem + 56320);
    const bf16_t* hin = (const bf16_t*)(p.ws + W_CS); bf16_t* yssd = (bf16_t*)(p.ws + W_YSSD);
    {
        float dtv, acum, alast; chunk_dt(p, ci, g * 8 + wid, lane, dtv, acum, alast);
        acl[wid * 64 + lane] = acum; dtl[wid * 64 + lane] = dtv;
    }
#pragma unroll
    for (int i = 0; i < 4; ++i) {
        const int item = tid + 512 * i, isC = item >> 10, it2 = item & 1023, s = it2 >> 4, chunk = it2 & 15;
        const int t = ci.c * 64 + s - ci.pad; float o[8];
        if (t >= 0 && t < ci.L) conv_ssd8(p, ci, t, SSDW + isC * 512 + g * 128 + chunk * 8, o);
        else {
#pragma unroll
            for (int j = 0; j < 8; ++j) o[j] = 0.f; }
        *(u32x4*)((isC ? Cs : Bs) + s * 136 + chunk * 8) = pack8(o);
    }
    __syncthreads();
    {
        const int tt = wid >> 1;
#pragma unroll
        for (int si = 0; si < 2; ++si) {
            const int st = (wid & 1) * 2 + si;
            f32x4 a = (f32x4){0.f, 0.f, 0.f, 0.f};
#pragma unroll
            for (int ks = 0; ks < 4; ++ks) {
                bf16x8 cf = *(const bf16x8*)(Cs + (tt * 16 + fr) * 136 + ks * 32 + fq * 8), bfg = *(const bf16x8*)(Bs + (st * 16 + fr) * 136 + ks * 32 + fq * 8);
                a = __builtin_amdgcn_mfma_f32_16x16x32_bf16(cf, bfg, a, 0, 0, 0);
            }
#pragma unroll
            for (int r = 0; r < 4; ++r) CB[(tt * 16 + fq * 4 + r) * 68 + st * 16 + fr] = a[r];
        }
    }
    __syncthreads();
    {
        const int h = g * 8 + wid;
        bf16_t* xt = XT + wid * (64 * 72);
        wave_xtile(p, ci, h, lane, xt, nullptr);
        bf16x8 hf[4][4];
#pragma unroll
        for (int pt = 0; pt < 4; ++pt) { const bf16_t* hp = hin + (((size_t)gc * 32 + h) * 64 + pt * 16 + fr) * 128 + fq * 8;
#pragma unroll
            for (int ks = 0; ks < 4; ++ks) hf[pt][ks] = *(const bf16x8*)(hp + ks * 32); }
        const float dsk = p.d_skip[h];
        const float* aw = acl + wid * 64; const float* dw = dtl + wid * 64;
#pragma unroll 1
        for (int tt = 0; tt < 4; ++tt) {
            const int tq = tt * 16 + fr;
            const int tok = ci.c * 64 + tq - ci.pad; const bool valid = tok >= 0 && tok < ci.L;
            const float at = aw[tq]; const float ea = __expf(at);
            bf16x8 mf[2], cf[4];
#pragma unroll
            for (int ks = 0; ks < 2; ++ks) {
                const int sb0 = ks * 32 + fq * 8;
                f32x4 c0 = *(const f32x4*)(CB + tq * 68 + sb0), c1 = *(const f32x4*)(CB + tq * 68 + sb0 + 4);
                f32x4 a0 = *(const f32x4*)(aw + sb0), a1 = *(const f32x4*)(aw + sb0 + 4), d0 = *(const f32x4*)(dw + sb0), d1 = *(const f32x4*)(dw + sb0 + 4);
                float mv[8];
#pragma unroll
                for (int j = 0; j < 4; ++j) { mv[j] = (sb0 + j) <= tq ? c0[j] * __expf(at - a0[j]) * d0[j] : 0.f; mv[4 + j] = (sb0 + 4 + j) <= tq ? c1[j] * __expf(at - a1[j]) * d1[j] : 0.f; }
                mf[ks] = __builtin_bit_cast(bf16x8, pack8(mv));
            }
#pragma unroll
            for (int ks = 0; ks < 4; ++ks) cf[ks] = *(const bf16x8*)(Cs + tq * 136 + ks * 32 + fq * 8);
#pragma unroll
            for (int pt = 0; pt < 4; ++pt) {
                f32x4 a1 = (f32x4){0.f, 0.f, 0.f, 0.f}, a2 = (f32x4){0.f, 0.f, 0.f, 0.f};
#pragma unroll
                for (int ks = 0; ks < 2; ++ks) { bf16x8 xf = *(const bf16x8*)(xt + (pt * 16 + fr) * 72 + ks * 32 + fq * 8); a1 = __builtin_amdgcn_mfma_f32_16x16x32_bf16(xf, mf[ks], a1, 0, 0, 0); }
#pragma unroll
                for (int ks = 0; ks < 4; ++ks) a2 = __builtin_amdgcn_mfma_f32_16x16x32_bf16(hf[pt][ks], cf[ks], a2, 0, 0, 0);
                f32x4 y;
#pragma unroll
                for (int r = 0; r < 4; ++r) y[r] = a1[r] + ea * a2[r] + dsk * bf2f(xt[(pt * 16 + fq * 4 + r) * 72 + tq]);
                if (valid) st_bf4(yssd + (size_t)(ci.rowbase + tok) * 2048 + h * 64 + pt * 16 + fq * 4, y);
            }
        }
    }
    __syncthreads();
}

__device__ __forceinline__ void phase_gate(const P& p) {
    bf16_t* yssd = (bf16_t*)(p.ws + W_YSSD); const bf16_t* zb = (const bf16_t*)(p.ws + W_ZB);
    const int wid = threadIdx.x >> 6, lane = threadIdx.x & 63;
    for (int task = blockIdx.x * 8 + wid; task < MR * 4; task += gridDim.x * 8) {
        const int row = task >> 2, g = task & 3;
        const size_t off = (size_t)row * 2048 + g * 512 + lane * 8;
        float y[8], z[8]; unpack8(__builtin_nontemporal_load((const u32x4*)(yssd + off)), y); unpack8(__builtin_nontemporal_load((const u32x4*)(zb + off)), z);
        float ss = 0.f;
#pragma unroll
        for (int j = 0; j < 8; ++j) { y[j] *= silu_f(z[j]); ss += y[j] * y[j]; }
        ss = wave_sum(ss);
        const float rinv = rsqrtf(ss * (1.f / 512.f) + EPS);
        const float* gp = p.g_ssd_norm + g * 512 + lane * 8; f32x4 g0 = *(const f32x4*)gp, g1 = *(const f32x4*)(gp + 4);
        y[0] *= rinv * g0[0]; y[1] *= rinv * g0[1]; y[2] *= rinv * g0[2]; y[3] *= rinv * g0[3];
        y[4] *= rinv * g1[0]; y[5] *= rinv * g1[1]; y[6] *= rinv * g1[2]; y[7] *= rinv * g1[3];
        *(u32x4*)(yssd + off) = pack8(y);
    }
}

constexpr int ACT_SEG = 47, ACT_NSEG = (MR + ACT_SEG - 1) / ACT_SEG, ACT_CG = DFF / 8;
struct ActRow { u32x4 g, v; };
__device__ __forceinline__ ActRow act_loadrow(const P& p, int row_t  , int rb, int sbs, int j0) {
    const bf16_t* upb = (const bf16_t*)(p.ws + W_UPB);
    ActRow r; r.g = (u32x4){0u, 0u, 0u, 0u}; r.v = r.g;
    if (row_t >= 0) { const bf16_t* q = upb + (size_t)(rb + row_t) * DFF2 + j0; r.g = *(const u32x4*)q; r.v = *(const u32x4*)(q + DFF); }
    else if (sbs >= 0) { const float* s = p.state_ffn_conv + ((size_t)sbs * 2 + (2 + row_t)) * DFF2 + j0;
        f32x4 a = *(const f32x4*)s, b = *(const f32x4*)(s + 4), c = *(const f32x4*)(s + DFF), d = *(const f32x4*)(s + DFF + 4);
        r.g.x = pk2(a[0], a[1]); r.g.y = pk2(a[2], a[3]); r.g.z = pk2(b[0], b[1]); r.g.w = pk2(b[2], b[3]);
        r.v.x = pk2(c[0], c[1]); r.v.y = pk2(c[2], c[3]); r.v.z = pk2(d[0], d[1]); r.v.w = pk2(d[2], d[3]); }
    return r;
}
__device__ __forceinline__ void phase_act(const P& p) {
    bf16_t* act = (bf16_t*)(p.ws + W_ACT);
    for (int T = blockIdx.x * NTHR + threadIdx.x; T < ACT_CG * ACT_NSEG; T += gridDim.x * NTHR) {
        const int seg = T / ACT_CG, j0 = (T - seg * ACT_CG) * 8;
        const int r0 = seg * ACT_SEG, r1 = (r0 + ACT_SEG) < MR ? (r0 + ACT_SEG) : MR;
        float wg[3][8], wv[3][8], bg[8], bv[8];
#pragma unroll
        for (int i = 0; i < 3; ++i) {
            const float* wp = p.conv_w_ffn + (size_t)i * DFF2 + j0; f32x4 a = *(const f32x4*)wp, b = *(const f32x4*)(wp + 4), c = *(const f32x4*)(wp + DFF), d = *(const f32x4*)(wp + DFF + 4);
            wg[i][0] = a[0]; wg[i][1] = a[1]; wg[i][2] = a[2]; wg[i][3] = a[3]; wg[i][4] = b[0]; wg[i][5] = b[1]; wg[i][6] = b[2]; wg[i][7] = b[3];
            wv[i][0] = c[0]; wv[i][1] = c[1]; wv[i][2] = c[2]; wv[i][3] = c[3]; wv[i][4] = d[0]; wv[i][5] = d[1]; wv[i][6] = d[2]; wv[i][7] = d[3];
        }
        { const float* bp = p.conv_b_ffn + j0; f32x4 a = *(const f32x4*)bp, b = *(const f32x4*)(bp + 4), c = *(const f32x4*)(bp + DFF), d = *(const f32x4*)(bp + DFF + 4);
          bg[0] = a[0]; bg[1] = a[1]; bg[2] = a[2]; bg[3] = a[3]; bg[4] = b[0]; bg[5] = b[1]; bg[6] = b[2]; bg[7] = b[3];
          bv[0] = c[0]; bv[1] = c[1]; bv[2] = c[2]; bv[3] = c[3]; bv[4] = d[0]; bv[5] = d[1]; bv[6] = d[2]; bv[7] = d[3]; }
        ActRow m2, m1, cur, nxt;
        int t, sbs, rb;
#define ACT_DECODE(row_) do { if ((row_) < NP) { const int b_ = (row_) / LP; t = (row_) - b_ * LP; rb = b_ * LP; sbs = -1; } else { const int r2_ = (row_) - NP; sbs = r2_ >> 4; t = r2_ & 15; rb = NP + sbs * LS; } } while (0)
        ACT_DECODE(r0);
        m2 = act_loadrow(p, t - 2, rb, sbs, j0); m1 = act_loadrow(p, t - 1, rb, sbs, j0); nxt = act_loadrow(p, t, rb, sbs, j0);
        for (int row = r0; row < r1; ++row) {
            cur = nxt;
            int tn = t + 1; const bool wrap = (sbs < 0) ? (tn == LP) : (tn == LS);
            ActRow n2 = m1, n1 = cur;
            if (row + 1 < r1) {
                if (wrap) { ACT_DECODE(row + 1); n2 = act_loadrow(p, -2, rb, sbs, j0); n1 = act_loadrow(p, -1, rb, sbs, j0); nxt = act_loadrow(p, 0, rb, sbs, j0); }
                else { t = tn; nxt = act_loadrow(p, t, rb, sbs, j0); }
            }
            float x0[8], x1[8], x2[8], y0[8], y1[8], y2[8], o[8];
            unpack8(m2.g, x0); unpack8(m1.g, x1); unpack8(cur.g, x2); unpack8(m2.v, y0); unpack8(m1.v, y1); unpack8(cur.v, y2);
#pragma unroll
            for (int j = 0; j < 8; ++j) {
                const float gg = bg[j] + wg[0][j] * x0[j] + wg[1][j] * x1[j] + wg[2][j] * x2[j];
                const float vv = bv[j] + wv[0][j] * y0[j] + wv[1][j] * y1[j] + wv[2][j] * y2[j];
                o[j] = silu_f(gg) * vv;
            }
            *(u32x4*)(act + (size_t)row * DFF + j0) = pack8(o);
            m2 = n2; m1 = n1;
        }
    }
}

__device__ __forceinline__ void phase_final(const P& p) {
    const bf16_t* h2 = (const bf16_t*)(p.ws + W_H1B); const float* rsq = (const float*)(p.ws + W_RSQ2);
    const int wid = threadIdx.x >> 6, lane = threadIdx.x & 63;
    for (int row = blockIdx.x * 8 + wid; row < MR; row += gridDim.x * 8) {
        float* o;
        if (row < NP) { const int b = row / LP, t = row - b * LP; if (t < 16) continue; o = p.out + O_YP + ((size_t)b * SEQ + (t - 16)) * DM; }
        else o = p.out + O_YS + (size_t)(row - NP) * DM;
        const float rinv = rsqrtf(__builtin_nontemporal_load(rsq + row) * (1.f / 1024.f) + EPS);
#pragma unroll
        for (int i = 0; i < 2; ++i) {
            const int c = i * 512 + lane * 8;
            float v[8]; unpack8(*(const u32x4*)(h2 + (size_t)row * 1024 + c), v);
            f32x4 g0 = *(const f32x4*)(p.g_final + c), g1 = *(const f32x4*)(p.g_final + c + 4);
            *(f32x4*)(o + c) = (f32x4){v[0] * rinv * g0[0], v[1] * rinv * g0[1], v[2] * rinv * g0[2], v[3] * rinv * g0[3]};
            *(f32x4*)(o + c + 4) = (f32x4){v[4] * rinv * g1[0], v[5] * rinv * g1[1], v[6] * rinv * g1[2], v[7] * rinv * g1[3]};
        }
    }
}

__global__ void __launch_bounds__(NTHR) fwd_kernel(P p, int ph0, int ph1, size_t dbg_off, size_t dbg_bytes) {
    unsigned* bar = (unsigned*)(p.ws + W_BAR);
#define GSYNC(i) do { asm volatile("s_waitcnt vmcnt(0) lgkmcnt(0)" ::: "memory"); __syncthreads(); \
        if (threadIdx.x == 0) { asm volatile("buffer_wbl2 sc1\n\ts_waitcnt vmcnt(0)" ::: "memory"); \
            const unsigned k_ = (unsigned)(i), g_ = blockIdx.x & 7u, ng_ = (gridDim.x + 7u - g_) >> 3, ngroups_ = gridDim.x < 8u ? gridDim.x : 8u; \
            const unsigned o1_ = __hip_atomic_fetch_add(bar + 64 * g_, 1u, __ATOMIC_RELAXED, __HIP_MEMORY_SCOPE_AGENT); \
            if (o1_ + 1u == k_ * ng_) { const unsigned o2_ = __hip_atomic_fetch_add(bar + 64 * 8, 1u, __ATOMIC_RELAXED, __HIP_MEMORY_SCOPE_AGENT); \
                if (o2_ + 1u == k_ * ngroups_) { _Pragma("unroll") for (int q_ = 0; q_ < 8; ++q_) __hip_atomic_store(bar + 640 + 32 * q_, k_, __ATOMIC_RELAXED, __HIP_MEMORY_SCOPE_AGENT); } } \
            while (__hip_atomic_load(bar + 640 + 32 * g_, __ATOMIC_RELAXED, __HIP_MEMORY_SCOPE_AGENT) < k_) __builtin_amdgcn_s_sleep(1); \
            asm volatile("buffer_inv sc1\n\ts_waitcnt vmcnt(0)" ::: "memory"); } \
        __syncthreads(); } while (0)
#define PHASE(i, ...) do { if (ph0 <= (i) && (i) < ph1) { if ((i) > ph0) GSYNC((i) - ph0); __VA_ARGS__ } __builtin_amdgcn_sched_barrier(0); } while (0)
    PHASE(0, phase_prep(p););
    PHASE(1, phase_gemm1a(p);
             { const int rem = (((MR + BM - 1) / BM) * (NA / BM)) % (int)gridDim.x;
               if (rem == 0) prep_transposes(p, 25 * 16, 1440, blockIdx.x, gridDim.x);
               else if ((int)blockIdx.x >= rem) prep_transposes(p, 25 * 16, 1440, blockIdx.x - rem, gridDim.x - rem); });
    PHASE(2, { const int wid = threadIdx.x >> 6;
               if (!SKIP_ATT) for (int t = (gridDim.x - 1 - blockIdx.x) * 8 + wid; t < ATT_TASKS; t += gridDim.x * 8) attn_wave(p, t);
               __syncthreads();
               for (int u = blockIdx.x; u < NGC * 4; u += gridDim.x) ssd1_unit(p, u); });
    PHASE(3, phase_scan(p););
    PHASE(4, for (int u = blockIdx.x; u < NGC * 4; u += gridDim.x) ssd3_unit(p, u););
    PHASE(5, phase_gemm1b(p););
    PHASE(6, phase_gate(p););
    PHASE(7, phase_gemm2(p););
    PHASE(8, phase_gemm3(p););
    PHASE(9, phase_gemm4(p););
    PHASE(10, phase_act(p););
    PHASE(11, phase_gemm5(p););
    PHASE(12, phase_final(p););
    if (dbg_bytes) { GSYNC(ph1 - ph0);
        const u32x4* src = (const u32x4*)(p.ws + dbg_off); u32x4* dst = (u32x4*)(p.out + O_YP);
        for (size_t i = (size_t)blockIdx.x * NTHR + threadIdx.x; i < dbg_bytes / 16; i += (size_t)gridDim.x * NTHR) dst[i] = src[i]; }
}

extern "C" void kernel_launch(void* const* d_in, const int* in_sizes, int n_in, void* d_out, int out_size, void* d_ws, size_t ws_size, hipStream_t stream) {
    (void)in_sizes; (void)n_in; (void)out_size;
    if (ws_size < W_END) { fprintf(stderr, "workspace too small: %zu < %zu\n", ws_size, (size_t)W_END); return; }
    P p{};
    const float** f = (const float**)&p;
    for (int i = 0; i < 25; ++i) f[i] = (const float*)d_in[i];
    p.out = (float*)d_out; p.ws = (char*)d_ws;
    (void)hipFuncSetAttribute((const void*)fwd_kernel, hipFuncAttributeMaxDynamicSharedMemorySize, SMEM_BYTES);
    int dev = 0, cus = 0, per_cu = 0;
    (void)hipGetDevice(&dev);
    (void)hipDeviceGetAttribute(&cus, hipDeviceAttributeMultiprocessorCount, dev);
    (void)hipOccupancyMaxActiveBlocksPerMultiprocessor(&per_cu, fwd_kernel, NTHR, SMEM_BYTES);
    if (per_cu < 1) per_cu = 1;
    int grid = cus * 1;
    size_t dbg_off = 0, dbg_bytes = 0;
    hipError_t e = hipSuccess;
#if SINGLE_LAUNCH
    int ph0 = 0, ph1 = 13;
    void* args[] = {&p, &ph0, &ph1, &dbg_off, &dbg_bytes};
    (void)hipMemsetAsync((char*)d_ws + W_BAR, 0, 4096, stream);
    e = hipLaunchCooperativeKernel((void*)fwd_kernel, dim3(grid), dim3(NTHR), args, SMEM_BYTES, stream);
#else
    for (int ph = 0; ph < NPH && e == hipSuccess; ++ph) {
        hipLaunchKernelGGL(fwd_kernel, dim3(grid), dim3(NTHR), SMEM_BYTES, stream, p, ph, ph + 1, dbg_off, (size_t)0);
        e = hipGetLastError();
    }
    if (NPH < 13) { dbg_off = W_CS; dbg_bytes = 33554432; hipLaunchKernelGGL(fwd_kernel, dim3(grid), dim3(NTHR), SMEM_BYTES, stream, p, 20, 20, dbg_off, dbg_bytes); }
#endif
    if (e != hipSuccess) fprintf(stderr, "cooperative launch failed: %s (grid %d)\n", hipGetErrorString(e), grid);
}
```
